# Optimizing an MI355X kernel written in HIP

```python
import jax
import jax.numpy as jnp
from jax import lax
import numpy as np

D_MODEL = 1024
BATCH = 32
SEQ = 2048
DEPTH = 1
DEC_BATCH = 16
DEC_SEQ = 4096
PAST_LEN = 128

GRID_W = 64
NA_HEADS = 8
NA_HEAD_DIM = D_MODEL // 16
NA_WIDTH = NA_HEADS * NA_HEAD_DIM
NA_KH_MAX = 8
NA_KW = 16
GLA_HEADS = 4
GLA_KEY_WIDTH = D_MODEL // 4
GLA_VAL_WIDTH = D_MODEL // 2
GLA_DK = GLA_KEY_WIDTH // GLA_HEADS
GLA_DV = GLA_VAL_WIDTH // GLA_HEADS
GLA_GATE_RANK = 16
GLA_GATE_NORMALIZER = 16.0
GLA_CHUNK = 16
D_FF = 4 * D_MODEL
RMS_EPS = 1e-6
IN_WIDTHS = (NA_WIDTH, NA_WIDTH, NA_WIDTH, GLA_KEY_WIDTH, GLA_KEY_WIDTH, GLA_VAL_WIDTH, GLA_VAL_WIDTH, GLA_GATE_RANK, GLA_GATE_RANK, D_MODEL, D_MODEL)
D_IN = sum(IN_WIDTHS)

kernel_name = 'hybrid_na_gla_encoder'


def rmsnorm(x, g):
    xf = x.astype(jnp.float32)
    xf = xf * lax.rsqrt(jnp.mean(xf * xf, axis=-1, keepdims=True) + RMS_EPS)
    return xf.astype(x.dtype) * g


def to_heads(t, n_heads):
    b, t_len, _ = t.shape
    return t.reshape(b, t_len, n_heads, -1).transpose(0, 2, 1, 3)


def from_heads(t):
    b, h, t_len, d = t.shape
    return t.transpose(0, 2, 1, 3).reshape(b, t_len, h * d)


def neighbourhood_attention(q, k, v, rpb):
    b, h, t_len, d = q.shape
    rows = t_len // GRID_W
    kh = min(NA_KH_MAX, rows)
    r = np.arange(rows)
    row_start = np.clip(r - kh // 2, 0, rows - kh)
    row_idx = row_start[:, None] + np.arange(kh)[None, :]
    dr_idx = row_idx - r[:, None] + (NA_KH_MAX - 1)
    c = np.arange(GRID_W)
    col_start = np.clip(c - NA_KW // 2, 0, GRID_W - NA_KW)
    col_mask = (c[None, :] >= col_start[:, None]) & (c[None, :] < col_start[:, None] + NA_KW)
    dc_idx = np.clip(c[None, :] - c[:, None], -(NA_KW - 1), NA_KW - 1) + (NA_KW - 1)
    qg = q.reshape(b, h, rows, GRID_W, d) * (d ** -0.5)
    kg = k.reshape(b, h, rows, GRID_W, d)[:, :, row_idx]
    vg = v.reshape(b, h, rows, GRID_W, d)[:, :, row_idx]
    bias = rpb[:, dr_idx[:, None, :, None], dc_idx[None, :, None, :]]
    s = jnp.einsum('bhrqd,bhrkcd->bhrqkc', qg, kg).astype(jnp.float32) + bias.astype(jnp.float32)
    s = jnp.where(col_mask[:, None, :], s, -jnp.inf)
    p = jax.nn.softmax(s.reshape(b, h, rows, GRID_W, kh * GRID_W), axis=-1)
    p = p.reshape(s.shape).astype(v.dtype)
    o = jnp.einsum('bhrqkc,bhrkcd->bhrqd', p, vg)
    return o.reshape(b, h, t_len, d)


def gla_chunked(q, k, v, log_a):
    b, h, t_len, dk = q.shape
    dv = v.shape[-1]
    n = t_len // GLA_CHUNK
    q, k, log_a = (t.astype(jnp.float32).reshape(b, h, n, GLA_CHUNK, dk) for t in (q, k, log_a))
    v = v.astype(jnp.float32).reshape(b, h, n, GLA_CHUNK, dv)
    cum = jnp.cumsum(log_a, axis=3)
    cum_last = cum[:, :, :, -1:, :]
    causal = np.tril(np.ones((GLA_CHUNK, GLA_CHUNK), dtype=bool))
    diff = cum[:, :, :, :, None, :] - cum[:, :, :, None, :, :]
    decay = jnp.exp(jnp.where(causal[:, :, None], diff, -jnp.inf))
    scores = jnp.einsum('bhnid,bhnjd,bhnijd->bhnij', q, k, decay)
    o_intra = jnp.einsum('bhnij,bhnjv->bhniv', scores, v)
    q_dec = q * jnp.exp(cum)
    k_dec = k * jnp.exp(cum_last - cum)
    chunk_decay = jnp.exp(cum_last[:, :, :, 0, :])

    def step(state, xs):
        qd, kd, vc, cd = xs
        o = jnp.einsum('bhid,bhdv->bhiv', qd, state)
        state = cd[..., None] * state + jnp.einsum('bhjd,bhjv->bhdv', kd, vc)
        return state, o

    xs = tuple(jnp.moveaxis(t, 2, 0) for t in (q_dec, k_dec, v, chunk_decay))
    state0 = jnp.zeros((b, h, dk, dv), jnp.float32)
    _, o_inter = lax.scan(step, state0, xs)
    return (o_intra + jnp.moveaxis(o_inter, 0, 2)).reshape(b, h, t_len, dv)


def gla_bidirectional(q, k, v, log_a_fwd, log_a_bwd):
    o_fwd = gla_chunked(q, k, v, log_a_fwd)
    flip = lambda t: jnp.flip(t, axis=2)
    o_bwd = flip(gla_chunked(flip(q), flip(k), flip(v), flip(log_a_bwd)))
    return o_fwd + o_bwd


def hybrid_mixer(u, w_in, b_in, na_rpb, gk_fwd_w, gk_fwd_b, gk_bwd_w, gk_bwd_b, gla_norm_g, w_br_na, w_br_gla, w_out):
    proj = jnp.einsum('btd,de->bte', u, w_in) + b_in
    split_points = np.cumsum(IN_WIDTHS)[:-1].tolist()
    (na_q, na_k, na_v, gla_q, gla_k, gla_v, gla_g, lr_fwd, lr_bwd, gate_na, gate_gla) = jnp.split(proj, split_points, axis=-1)
    na_o = neighbourhood_attention(to_heads(na_q, NA_HEADS), to_heads(na_k, NA_HEADS), to_heads(na_v, NA_HEADS), na_rpb)
    na_out = jnp.einsum('bte,ed->btd', from_heads(na_o), w_br_na)
    log_a_fwd = jax.nn.log_sigmoid((jnp.einsum('btr,rk->btk', lr_fwd, gk_fwd_w) + gk_fwd_b).astype(jnp.float32)) / GLA_GATE_NORMALIZER
    log_a_bwd = jax.nn.log_sigmoid((jnp.einsum('btr,rk->btk', lr_bwd, gk_bwd_w) + gk_bwd_b).astype(jnp.float32)) / GLA_GATE_NORMALIZER
    gla_o = gla_bidirectional(to_heads(gla_q, GLA_HEADS) * (GLA_DK ** -0.5), to_heads(gla_k, GLA_HEADS), to_heads(gla_v, GLA_HEADS), to_heads(log_a_fwd, GLA_HEADS), to_heads(log_a_bwd, GLA_HEADS))
    gla_o = rmsnorm(gla_o.astype(u.dtype), gla_norm_g)
    gla_o = from_heads(gla_o) * jax.nn.silu(gla_g)
    gla_out = jnp.einsum('bte,ed->btd', gla_o, w_br_gla)
    merged = jax.nn.sigmoid(gate_na) * na_out + jax.nn.sigmoid(gate_gla) * gla_out
    return jnp.einsum('btd,de->bte', merged, w_out)


def sq_relu_mlp(u, w_up, w_down):
    hdn = jnp.square(jax.nn.relu(jnp.einsum('btd,df->btf', u, w_up)))
    return jnp.einsum('btf,fd->btd', hdn, w_down)


def trunk(x, norm_mix_g, w_in, b_in, na_rpb, gk_fwd_w, gk_fwd_b, gk_bwd_w, gk_bwd_b, gla_norm_g, w_br_na, w_br_gla, w_out, norm_mlp_g, w_up, w_down, norm_final_g):
    h = x
    for l in range(DEPTH):
        h = h + hybrid_mixer(rmsnorm(h, norm_mix_g[l]), w_in[l], b_in[l], na_rpb[l], gk_fwd_w[l], gk_fwd_b[l], gk_bwd_w[l], gk_bwd_b[l], gla_norm_g[l], w_br_na[l], w_br_gla[l], w_out[l])
        h = h + sq_relu_mlp(rmsnorm(h, norm_mlp_g[l]), w_up[l], w_down[l])
    return rmsnorm(h, norm_final_g)


def setup_inputs(seed: int = 0) -> dict:
    key = jax.random.key(seed)
    ks = jax.random.split(key, 20)

    def nrm(k, shape, scale):
        return jax.random.normal(k, shape, jnp.float32) * scale

    return {
        'x_prompt': nrm(ks[0], (BATCH, SEQ, D_MODEL), 1.0),
        'x_sample': nrm(ks[1], (DEC_BATCH, DEC_SEQ, D_MODEL), 1.0),
        'norm_mix_g': 1.0 + nrm(ks[2], (DEPTH, D_MODEL), 0.01),
        'w_in': nrm(ks[3], (DEPTH, D_MODEL, D_IN), D_MODEL ** -0.5),
        'b_in': nrm(ks[4], (DEPTH, D_IN), 0.01),
        'na_rpb': nrm(ks[5], (DEPTH, NA_HEADS, 2 * NA_KH_MAX - 1, 2 * NA_KW - 1), 0.02),
        'gk_fwd_w': nrm(ks[6], (DEPTH, GLA_GATE_RANK, GLA_KEY_WIDTH), GLA_GATE_RANK ** -0.5),
        'gk_fwd_b': nrm(ks[7], (DEPTH, GLA_KEY_WIDTH), 0.01),
        'gk_bwd_w': nrm(ks[8], (DEPTH, GLA_GATE_RANK, GLA_KEY_WIDTH), GLA_GATE_RANK ** -0.5),
        'gk_bwd_b': nrm(ks[9], (DEPTH, GLA_KEY_WIDTH), 0.01),
        'gla_norm_g': 1.0 + nrm(ks[10], (DEPTH, GLA_DV), 0.01),
        'w_br_na': nrm(ks[11], (DEPTH, NA_WIDTH, D_MODEL), NA_WIDTH ** -0.5),
        'w_br_gla': nrm(ks[12], (DEPTH, GLA_VAL_WIDTH, D_MODEL), GLA_VAL_WIDTH ** -0.5),
        'w_out': nrm(ks[13], (DEPTH, D_MODEL, D_MODEL), D_MODEL ** -0.5),
        'norm_mlp_g': 1.0 + nrm(ks[14], (DEPTH, D_MODEL), 0.01),
        'w_up': nrm(ks[15], (DEPTH, D_MODEL, D_FF), D_MODEL ** -0.5),
        'w_down': nrm(ks[16], (DEPTH, D_FF, D_MODEL), D_FF ** -0.5),
        'norm_final_g': 1.0 + nrm(ks[17], (D_MODEL,), 0.01),
    }


def reference(x_prompt, x_sample, norm_mix_g, w_in, b_in, na_rpb, gk_fwd_w, gk_fwd_b, gk_bwd_w, gk_bwd_b, gla_norm_g, w_br_na, w_br_gla, w_out, norm_mlp_g, w_up, w_down, norm_final_g):
    y_prompt = trunk(x_prompt, norm_mix_g, w_in, b_in, na_rpb, gk_fwd_w, gk_fwd_b, gk_bwd_w, gk_bwd_b, gla_norm_g, w_br_na, w_br_gla, w_out, norm_mlp_g, w_up, w_down, norm_final_g)
    y_sample = trunk(x_sample, norm_mix_g, w_in, b_in, na_rpb, gk_fwd_w, gk_fwd_b, gk_bwd_w, gk_bwd_b, gla_norm_g, w_br_na, w_br_gla, w_out, norm_mlp_g, w_up, w_down, norm_final_g)
    return (y_prompt, y_sample)
```

```cpp
#include <hip/hip_runtime.h>
#include <hip/hip_cooperative_groups.h>
#include <cstdio>
#include <cstdint>
namespace cg = cooperative_groups;

#ifndef MK_SINGLE
#define MK_SINGLE 1
#endif

constexpr int DM = 1024, DFF = 4096, NP = 5376  , SBTOK = 65536;
constexpr int C_NAQ = 0, C_NAK = 512, C_NAV = 1024, C_GQ = 1536, C_GK = 1792, C_GV = 2048, C_GG = 2560, C_SNA = 3072, C_SGLA = 4096, C_LR = 5120;
constexpr float RMS_EPS = 1e-6f;
namespace pg8 {
#define PG8_LAS __attribute__((address_space(3)))
typedef unsigned short bf16_t;
typedef short bf16x8 __attribute__((ext_vector_type(8)));
typedef float f32x4 __attribute__((ext_vector_type(4)));
typedef unsigned u32x4 __attribute__((ext_vector_type(4)));
constexpr int BM = 256, BK = 64, HALF = 128, HTB = HALF * BK * 2  , STAGE_BYTES = 8 * HTB, NXCD = 8, WGM = 8;

__host__ __device__ __forceinline__ int lds_byte(int r, int c) { const int st = (r >> 4) * 2 + (c >> 5), rr = r & 15, cc = c & 31, ob = rr * 64 + cc * 2; return st * 1024 + (ob ^ (((ob >> 9) & 1) << 5)); }
__host__ __device__ __forceinline__ void stage_rc(int b, int& R, int& C) { const int st = b / 1024, sb = b % 1024, swz = sb ^ (((sb >> 9) & 1) << 5); R = (st >> 1) * 16 + swz / 64; C = (st & 1) * 32 + (swz % 64) / 2; }
__host__ __device__ __forceinline__ int perm32(int rho) { const int n = rho >> 4, i = rho & 15; return 8 * (i >> 2) + 4 * n + (i & 3); }

struct Unit { int pm, pn; };
struct Gemm { const bf16_t* A; const bf16_t* Bt; int M, N, K; };

struct StaticOrder {
    int nM, nN, nwg, G, c;
    __host__ __device__ void init(int M, int N, int G_, int c_) { nM = M / BM; nN = N / BM; nwg = nM * nN; G = G_; c = c_; }
    __host__ __device__ bool next(int i, Unit& u) const {
        const long L = (long)i * G + c; if (L >= nwg) return false;
        int wgid = (int)L; { const int q = nwg / NXCD, r = nwg % NXCD, xcd = wgid % NXCD, off = wgid / NXCD; wgid = (xcd < r ? xcd * (q + 1) : r * (q + 1) + (xcd - r) * q) + off; }
        const int nig = WGM * nN, gid = wgid / nig, fm = gid * WGM, gsz = (nM - fm) < WGM ? (nM - fm) : WGM;
        u.pm = fm + ((wgid % nig) % gsz); u.pn = (wgid % nig) / gsz; return true;
    }
    __device__ __forceinline__ void a_ready(const Unit&) const {}
    __device__ __forceinline__ void done(const Unit&) const {}
};

__device__ __forceinline__ unsigned cvt_pk_bf16(float lo, float hi) { unsigned r; asm volatile("v_cvt_pk_bf16_f32 %0, %1, %2" : "=v"(r) : "v"(lo), "v"(hi)); return r; }
typedef unsigned u32x2 __attribute__((ext_vector_type(2)));
__device__ __forceinline__ float bf2f(unsigned short b) { return __uint_as_float((unsigned)b << 16); }
__device__ __forceinline__ float sigmoidf_(float x) { return __builtin_amdgcn_rcpf(1.0f + __expf(-x)); }

struct EpiProj {
    static constexpr bool PERM = true, AFTER_DRAIN = false, MID = false; static constexpr int NARROW_PN = 20;
    bf16_t* O; const float* bias;
    __device__ __forceinline__ void operator()(const f32x4 (&acc)[2][2][4][2], const Unit& u, int wr, int wc, int fr, int fq) const {
        const int row0 = u.pm * BM + wr * 64 + fr, pn = u.pn;
        const int mode = (pn < 2 || pn == 6) ? 1 : ((pn == 10 || pn == 11) ? 2 : ((pn >= 12 && pn < 20) ? 3 : 0));
        const int col0 = pn * BM + wc * 32 + 8 * fq;
        f32x4 bv[2][2];
#pragma unroll
        for (int bj = 0; bj < 2; ++bj)
#pragma unroll
            for (int n = 0; n < 2; ++n) bv[bj][n] = *(const f32x4*)(bias + col0 + bj * HALF + 4 * n);
#pragma unroll
        for (int ai = 0; ai < 2; ++ai)
#pragma unroll
            for (int m = 0; m < 4; ++m) { bf16_t* rowp = O + (size_t)(row0 + ai * HALF + m * 16) * NP + col0;
#pragma unroll
                for (int bj = 0; bj < 2; ++bj) { f32x4 v0 = acc[ai][bj][m][0] + bv[bj][0], v1 = acc[ai][bj][m][1] + bv[bj][1];
                    if (mode == 1) { v0 = v0 * 0.125f; v1 = v1 * 0.125f; }
                    else if (mode == 2) {
#pragma unroll
                        for (int e = 0; e < 4; ++e) { v0[e] = v0[e] * sigmoidf_(v0[e]); v1[e] = v1[e] * sigmoidf_(v1[e]); } }
                    else if (mode == 3) {
#pragma unroll
                        for (int e = 0; e < 4; ++e) { v0[e] = sigmoidf_(v0[e]); v1[e] = sigmoidf_(v1[e]); } }
                    u32x4 w; w.x = cvt_pk_bf16(v0[0], v0[1]); w.y = cvt_pk_bf16(v0[2], v0[3]); w.z = cvt_pk_bf16(v1[0], v1[1]); w.w = cvt_pk_bf16(v1[2], v1[3]);
                    *(u32x4*)(rowp + bj * HALF) = w; } }
    }
};

template <bool ADD> struct EpiBranch {
    static constexpr bool PERM = true, AFTER_DRAIN = false, MID = false; static constexpr int NARROW_PN = -1;
    const bf16_t* proj; int gcol; bf16_t* O;
    __device__ __forceinline__ void operator()(const f32x4 (&acc)[2][2][4][2], const Unit& u, int wr, int wc, int fr, int fq) const {
        const int row0 = u.pm * BM + wr * 64 + fr, col0 = u.pn * BM + wc * 32 + 8 * fq;
#pragma unroll
        for (int ai = 0; ai < 2; ++ai)
#pragma unroll
            for (int m = 0; m < 4; ++m) { const size_t r = (size_t)(row0 + ai * HALF + m * 16);
#pragma unroll
                for (int bj = 0; bj < 2; ++bj) {
                    const u32x4 gw = *(const u32x4*)(proj + r * NP + gcol + col0 + bj * HALF);
                    u32x4 pw = (u32x4){0u, 0u, 0u, 0u}; if (ADD) pw = *(const u32x4*)(O + r * DM + col0 + bj * HALF);
                    float o[8];
#pragma unroll
                    for (int e = 0; e < 8; ++e) { const unsigned g2 = gw[e >> 1], p2 = pw[e >> 1];
                        const float gt = (e & 1) ? __uint_as_float(g2 & 0xffff0000u) : __uint_as_float(g2 << 16);
                        const float pv = (e & 1) ? __uint_as_float(p2 & 0xffff0000u) : __uint_as_float(p2 << 16);
                        o[e] = pv + gt * acc[ai][bj][m][e >> 2][e & 3]; }
                    u32x4 w; w.x = cvt_pk_bf16(o[0], o[1]); w.y = cvt_pk_bf16(o[2], o[3]); w.z = cvt_pk_bf16(o[4], o[5]); w.w = cvt_pk_bf16(o[6], o[7]);
                    *(u32x4*)(O + r * DM + col0 + bj * HALF) = w; }
                asm volatile("" ::: "memory"); }
    }
};

struct EpiBranchFused {
    static constexpr bool PERM = true, AFTER_DRAIN = false, MID = true; static constexpr int NARROW_PN = -1;
    const bf16_t* proj; bf16_t* O;
    __device__ __forceinline__ void mid(f32x4 (&acc)[2][2][4][2], const Unit& u, int wr, int wc, int fr_in, int fq_in) const {
        int fr = fr_in, fq = fq_in; asm volatile("" : "+v"(fr), "+v"(fq));
        const int row0 = u.pm * BM + wr * 64 + fr, col0 = u.pn * BM + wc * 32 + 8 * fq;
#pragma unroll
        for (int ai = 0; ai < 2; ++ai)
#pragma unroll
            for (int m = 0; m < 4; ++m) { const size_t r = (size_t)(row0 + ai * HALF + m * 16);
#pragma unroll
                for (int bj = 0; bj < 2; ++bj) {
                    const u32x4 ga = *(const u32x4*)(proj + r * NP + C_SNA + col0 + bj * HALF), gb = *(const u32x4*)(proj + r * NP + C_SGLA + col0 + bj * HALF);
#pragma unroll
                    for (int e = 0; e < 8; ++e) { const unsigned a2 = ga[e >> 1], b2 = gb[e >> 1];
                        const float sa = (e & 1) ? __uint_as_float(a2 & 0xffff0000u) : __uint_as_float(a2 << 16), sb = (e & 1) ? __uint_as_float(b2 & 0xffff0000u) : __uint_as_float(b2 << 16);
                        acc[ai][bj][m][e >> 2][e & 3] *= sa * __builtin_amdgcn_rcpf(sb); } }
                if (m == 3) asm volatile("" ::: "memory"); }
    }
    __device__ __forceinline__ void operator()(const f32x4 (&acc)[2][2][4][2], const Unit& u, int wr, int wc, int fr, int fq) const {
        const int row0 = u.pm * BM + wr * 64 + fr, col0 = u.pn * BM + wc * 32 + 8 * fq;
#pragma unroll
        for (int ai = 0; ai < 2; ++ai)
#pragma unroll
            for (int m = 0; m < 4; ++m) { const size_t r = (size_t)(row0 + ai * HALF + m * 16);
#pragma unroll
                for (int bj = 0; bj < 2; ++bj) {
                    const u32x4 gb = *(const u32x4*)(proj + r * NP + C_SGLA + col0 + bj * HALF);
                    float o[8];
#pragma unroll
                    for (int e = 0; e < 8; ++e) { const unsigned b2 = gb[e >> 1]; const float sb = (e & 1) ? __uint_as_float(b2 & 0xffff0000u) : __uint_as_float(b2 << 16);
                        o[e] = sb * acc[ai][bj][m][e >> 2][e & 3]; }
                    u32x4 w; w.x = cvt_pk_bf16(o[0], o[1]); w.y = cvt_pk_bf16(o[2], o[3]); w.z = cvt_pk_bf16(o[4], o[5]); w.w = cvt_pk_bf16(o[6], o[7]);
                    *(u32x4*)(O + r * DM + col0 + bj * HALF) = w; }
                if (m == 3) asm volatile("" ::: "memory"); }
    }
};

struct EpiOut {
    static constexpr bool PERM = false, AFTER_DRAIN = false, MID = false; static constexpr int NARROW_PN = -1;
    const float* base; bf16_t* hb; float* ssq;
    __device__ __forceinline__ void operator()(const f32x4 (&acc)[2][2][4][2], const Unit& u, int wr, int wc, int fr, int fq) const {
        const int col0 = u.pn * BM + wc * 32 + 4 * fq;
#pragma unroll
        for (int ai = 0; ai < 2; ++ai) {
            f32x4 xv[4][2][2];
#pragma unroll
            for (int m = 0; m < 4; ++m) { const size_t r = (size_t)(u.pm * BM + ai * HALF + wr * 64 + m * 16 + fr);
#pragma unroll
                for (int bj = 0; bj < 2; ++bj)
#pragma unroll
                    for (int n = 0; n < 2; ++n) xv[m][bj][n] = *(const f32x4*)(base + r * DM + col0 + bj * HALF + n * 16); }
#pragma unroll
            for (int m = 0; m < 4; ++m) { const size_t r = (size_t)(u.pm * BM + ai * HALF + wr * 64 + m * 16 + fr); float s = 0.f;
#pragma unroll
                for (int bj = 0; bj < 2; ++bj)
#pragma unroll
                    for (int n = 0; n < 2; ++n) { const size_t off = r * DM + col0 + bj * HALF + n * 16;
                        const f32x4 h = xv[m][bj][n] + acc[ai][bj][m][n];
                        s += (h[0] * h[0] + h[1] * h[1]) + (h[2] * h[2] + h[3] * h[3]);
                        u32x2 w; w.x = cvt_pk_bf16(h[0], h[1]); w.y = cvt_pk_bf16(h[2], h[3]); *(u32x2*)(hb + off) = w; }
                s += __shfl_xor(s, 16); s += __shfl_xor(s, 32);
                if (fq == 0) atomicAdd(ssq + r, s); }
            asm volatile("" ::: "memory"); }
    }
};
struct EpiDownNorm {
    static constexpr bool PERM = false, AFTER_DRAIN = false, MID = false; static constexpr int NARROW_PN = -1;
    const bf16_t* hb; float* out; float* ssq; unsigned* cnt; const float* gain;
    __device__ __forceinline__ void operator()(const f32x4 (&acc_)[2][2][4][2], const Unit& u, int wr, int wc, int fr, int fq) const {
        f32x4 (&acc)[2][2][4][2] = const_cast<f32x4 (&)[2][2][4][2]>(acc_);
        const int col0 = u.pn * BM + wc * 32 + 4 * fq;
#pragma unroll
        for (int ai = 0; ai < 2; ++ai) {
            u32x2 hv[4][2][2];
#pragma unroll
            for (int m = 0; m < 4; ++m) { const size_t r = (size_t)(u.pm * BM + ai * HALF + wr * 64 + m * 16 + fr);
#pragma unroll
                for (int bj = 0; bj < 2; ++bj)
#pragma unroll
                    for (int n = 0; n < 2; ++n) hv[m][bj][n] = *(const u32x2*)(hb + r * DM + col0 + bj * HALF + n * 16); }
#pragma unroll
            for (int m = 0; m < 4; ++m) { const size_t r = (size_t)(u.pm * BM + ai * HALF + wr * 64 + m * 16 + fr); float s = 0.f;
#pragma unroll
                for (int bj = 0; bj < 2; ++bj)
#pragma unroll
                    for (int n = 0; n < 2; ++n) { const u32x2 hw = hv[m][bj][n];
                        f32x4 h = acc[ai][bj][m][n];
                        h[0] += __uint_as_float(hw.x << 16); h[1] += __uint_as_float(hw.x & 0xffff0000u); h[2] += __uint_as_float(hw.y << 16); h[3] += __uint_as_float(hw.y & 0xffff0000u);
                        acc[ai][bj][m][n] = h; s += (h[0] * h[0] + h[1] * h[1]) + (h[2] * h[2] + h[3] * h[3]); }
                s += __shfl_xor(s, 16); s += __shfl_xor(s, 32);
                if (fq == 0) atomicAdd(ssq + r, s); }
            asm volatile("" ::: "memory"); }
        asm volatile("s_waitcnt vmcnt(0)" ::: "memory");
        if ((threadIdx.x & 63) == 0) __hip_atomic_fetch_add(cnt + u.pm, 1u, __ATOMIC_RELAXED, __HIP_MEMORY_SCOPE_AGENT);
        {   unsigned spins = 0;
            while ((unsigned)__builtin_amdgcn_readfirstlane((int)__hip_atomic_load(cnt + u.pm, __ATOMIC_RELAXED, __HIP_MEMORY_SCOPE_AGENT)) < 32u) { __builtin_amdgcn_s_sleep(2); if (++spins > (1u << 22)) break; } }
        asm volatile("" ::: "memory");
#pragma unroll
        for (int ai = 0; ai < 2; ++ai)
#pragma unroll
            for (int m = 0; m < 4; ++m) { const size_t r = (size_t)(u.pm * BM + ai * HALF + wr * 64 + m * 16 + fr);
                const float rstd = rsqrtf(__hip_atomic_load(ssq + r, __ATOMIC_RELAXED, __HIP_MEMORY_SCOPE_AGENT) * (1.0f / DM) + RMS_EPS);
#pragma unroll
                for (int bj = 0; bj < 2; ++bj)
#pragma unroll
                    for (int n = 0; n < 2; ++n) { const size_t off = r * DM + col0 + bj * HALF + n * 16; const f32x4 gg = *(const f32x4*)(gain + col0 + bj * HALF + n * 16);
                        *(f32x4*)(out + off) = acc[ai][bj][m][n] * rstd * gg; }
                asm volatile("" ::: "memory"); }
    }
};

struct EpiUp {
    static constexpr bool PERM = true, AFTER_DRAIN = false, MID = false; static constexpr int NARROW_PN = -1;
    const float* ssq; bf16_t* O;
    __device__ __forceinline__ void operator()(const f32x4 (&acc)[2][2][4][2], const Unit& u, int wr, int wc, int fr, int fq) const {
        const int row0 = u.pm * BM + wr * 64 + fr, col0 = u.pn * BM + wc * 32 + 8 * fq;
#pragma unroll
        for (int ai = 0; ai < 2; ++ai)
#pragma unroll
            for (int m = 0; m < 4; ++m) { const size_t r = (size_t)(row0 + ai * HALF + m * 16);
                const float rstd = rsqrtf(ssq[r] * (1.0f / DM) + RMS_EPS);
#pragma unroll
                for (int bj = 0; bj < 2; ++bj) { f32x4 v0 = acc[ai][bj][m][0] * rstd, v1 = acc[ai][bj][m][1] * rstd;
#pragma unroll
                    for (int e = 0; e < 4; ++e) { const float a = fmaxf(v0[e], 0.f), b = fmaxf(v1[e], 0.f); v0[e] = a * a; v1[e] = b * b; }
                    u32x4 w; w.x = cvt_pk_bf16(v0[0], v0[1]); w.y = cvt_pk_bf16(v0[2], v0[3]); w.z = cvt_pk_bf16(v1[0], v1[1]); w.w = cvt_pk_bf16(v1[2], v1[3]);
                    const int col = col0 + bj * HALF;
                    *(u32x4*)(O + ((((r >> 8) * (DFF / 64) + (col >> 6)) * 256 + (r & 255)) * 64 + (col & 63))) = w; } }
    }
};

template <class Epi, class Sched, bool ALIGN_EPI = false, bool SP2 = false, bool TILED = false>
__device__ __forceinline__ void gemm_phase(PG8_LAS unsigned char* lds, const Gemm g, const Sched& S, const Epi& E) {
    int tid_ = threadIdx.x; asm volatile("" : "+v"(tid_));
    const int tid = tid_, wid = __builtin_amdgcn_readfirstlane(tid >> 6), lane = tid & 63, wr = wid >> 2, wc = wid & 3, fr = lane & 15, fq = lane >> 4;
    const int K = g.K, nt = K / BK;
    unsigned voffA[2], voffB[2];
#pragma unroll
    for (int i = 0; i < 2; ++i) { int R, C; stage_rc(tid * 16 + i * 8192, R, C); const int Rb = Epi::PERM ? ((R & ~31) + perm32(R & 31)) : R;
        const int rs = TILED ? BK : K; voffA[i] = (unsigned)(R * rs + C) * 2u; voffB[i] = (unsigned)(Rb * rs + C) * 2u; }
    const size_t kstep = TILED ? (size_t)(BM * BK * 2) : (size_t)(BK * 2);
    const size_t hstep = TILED ? (size_t)(HALF * BK * 2) : (size_t)HALF * K * 2;
    const size_t tstep = TILED ? (size_t)(K / BK) * (BM * BK * 2) : 2 * hstep;
    const unsigned ldsw = (unsigned)wid * 1024u;
    const int aoff = lds_byte(wr * 64 + fr, fq * 8), boff = lds_byte(wc * 32 + fr, fq * 8);
#define PG8_SA(b, h) (((b) * 2 + (h)) * HTB)
#define PG8_SB(b, h) ((4 + (b) * 2 + (h)) * HTB)
#define PG8_STAGE(bufoff, gbase, voff) do { _Pragma("unroll") for (int _i = 0; _i < 2; ++_i) \
        __builtin_amdgcn_global_load_lds((const unsigned*)((const char*)(gbase) + (voff)[_i]), (PG8_LAS unsigned*)(lds + (bufoff) + ldsw + _i * 8192), 16, 0, 0); } while (0)
#define PG8_LDA(dst, b, h) do { _Pragma("unroll") for (int m = 0; m < 4; ++m) _Pragma("unroll") for (int k = 0; k < 2; ++k) dst[m][k] = *(const PG8_LAS bf16x8*)(lds + PG8_SA(b, h) + aoff + m * 2048 + k * 1024); } while (0)
#define PG8_LDB(dst, b, h) do { _Pragma("unroll") for (int n = 0; n < 2; ++n) _Pragma("unroll") for (int k = 0; k < 2; ++k) dst[n][k] = *(const PG8_LAS bf16x8*)(lds + PG8_SB(b, h) + boff + n * 2048 + k * 1024); } while (0)
#define PG8_MMA(ai, bj, At, Bt) do { if (Epi::NARROW_PN < 0 || ((bj) ? mma_on1 : mma_on0)) { __builtin_amdgcn_s_setprio(1); _Pragma("unroll") for (int m = 0; m < 4; ++m) _Pragma("unroll") for (int n = 0; n < 2; ++n) _Pragma("unroll") for (int k = 0; k < 2; ++k) \
        acc[ai][bj][m][n] = __builtin_amdgcn_mfma_f32_16x16x32_bf16(Bt[n][k], At[m][k], acc[ai][bj][m][n], 0, 0, 0); __builtin_amdgcn_s_setprio(0); } } while (0)
#define PG8_WAIT_V(n) asm volatile("s_waitcnt vmcnt(" #n ")" ::: "memory")
#define PG8_WAIT_L(n) asm volatile("s_waitcnt lgkmcnt(" #n ")" ::: "memory")
#define PG8_BAR __builtin_amdgcn_s_barrier()
#define PG8_SCHED __builtin_amdgcn_sched_barrier(0)
    Unit cur, nxt; int ui = 0;
    if (!S.next(0, cur)) return;
    bool mma_on0 = true, mma_on1 = true;
    if constexpr (Epi::NARROW_PN >= 0) { const bool nar = (cur.pn == Epi::NARROW_PN); mma_on0 = !nar || (wc == 0); mma_on1 = !nar; }
    f32x4 acc[2][2][4][2];
#pragma unroll
    for (int a = 0; a < 2; ++a)
#pragma unroll
        for (int b = 0; b < 2; ++b)
#pragma unroll
            for (int m = 0; m < 4; ++m)
#pragma unroll
                for (int n = 0; n < 2; ++n) acc[a][b][m][n] = (f32x4){0.f, 0.f, 0.f, 0.f};
    bf16x8 At[4][2], B0[2][2], B1[2][2];
    const char* cA = (const char*)g.A + (size_t)cur.pm * tstep; const char* cB = (const char*)g.Bt + (size_t)cur.pn * tstep;
    S.a_ready(cur);
    if constexpr (SP2) {
        PG8_STAGE(PG8_SB(0, 0), cB, voffB); PG8_STAGE(PG8_SB(0, 1), cB + hstep, voffB); PG8_STAGE(PG8_SA(0, 0), cA, voffA); PG8_STAGE(PG8_SA(0, 1), cA + hstep, voffA);
        if (wr == 1) PG8_BAR;
        PG8_WAIT_V(2); PG8_BAR;
        PG8_STAGE(PG8_SB(1, 0), cB + kstep, voffB); PG8_STAGE(PG8_SA(1, 0), cA + kstep, voffA); PG8_STAGE(PG8_SB(1, 1), cB + hstep + kstep, voffB);
        PG8_WAIT_V(6); PG8_BAR;
    } else {
        PG8_STAGE(PG8_SB(0, 0), cB, voffB); PG8_STAGE(PG8_SA(0, 0), cA, voffA); PG8_STAGE(PG8_SB(0, 1), cB + hstep, voffB); PG8_STAGE(PG8_SA(0, 1), cA + hstep, voffA);
        if (wr == 1) PG8_BAR;
        PG8_WAIT_V(4); PG8_BAR;
        PG8_STAGE(PG8_SB(1, 0), cB + kstep, voffB); PG8_STAGE(PG8_SA(1, 0), cA + kstep, voffA); PG8_STAGE(PG8_SB(1, 1), cB + hstep + kstep, voffB);
        PG8_WAIT_V(6); PG8_BAR;
    }
    for (;;) {
        const bool has_next = S.next(ui + 1, nxt);
        const char* nA = has_next ? (const char*)g.A + (size_t)nxt.pm * tstep : cA; const char* nB = has_next ? (const char*)g.Bt + (size_t)nxt.pn * tstep : cB;
        for (int t = 0; t < nt; t += 2) {
            const bool last = (t == nt - 2);
            const char* a1 = cA + (size_t)(t + 1) * kstep;
            const char* a2 = last ? nA : cA + (size_t)(t + 2) * kstep; const char* b2 = last ? nB : cB + (size_t)(t + 2) * kstep;
            const char* a3 = a2 + kstep; const char* b3 = b2 + kstep;
            if (last && has_next) S.a_ready(nxt);
            if constexpr (Epi::MID) { if (t == nt / 2) E.mid(acc, cur, wr, wc, fr, fq); }
            if constexpr (SP2) {
            PG8_LDB(B0, 0, 0); PG8_LDB(B1, 0, 1); PG8_SCHED; PG8_LDA(At, 0, 0); PG8_STAGE(PG8_SA(1, 1), a1 + hstep, voffA);
            PG8_WAIT_V(8); PG8_WAIT_L(0); PG8_BAR; PG8_MMA(0, 0, At, B0); PG8_MMA(0, 1, At, B1); PG8_BAR; PG8_SCHED;
            PG8_LDA(At, 0, 1); PG8_STAGE(PG8_SB(0, 0), b2, voffB); PG8_STAGE(PG8_SB(0, 1), b2 + hstep, voffB); PG8_STAGE(PG8_SA(0, 0), a2, voffA);
            PG8_WAIT_V(8); PG8_WAIT_L(0); PG8_BAR; PG8_MMA(1, 0, At, B0); PG8_MMA(1, 1, At, B1); PG8_BAR; PG8_SCHED;
            PG8_LDB(B0, 1, 0); PG8_LDB(B1, 1, 1); PG8_SCHED; PG8_LDA(At, 1, 0); PG8_STAGE(PG8_SA(0, 1), a2 + hstep, voffA);
            PG8_WAIT_V(8); PG8_WAIT_L(0); PG8_BAR; PG8_MMA(0, 0, At, B0); PG8_MMA(0, 1, At, B1); PG8_BAR; PG8_SCHED;
            PG8_LDA(At, 1, 1); PG8_STAGE(PG8_SB(1, 0), b3, voffB); PG8_STAGE(PG8_SB(1, 1), b3 + hstep, voffB); PG8_STAGE(PG8_SA(1, 0), a3, voffA);
            PG8_WAIT_V(8); PG8_WAIT_L(0); PG8_BAR; PG8_MMA(1, 0, At, B0); PG8_MMA(1, 1, At, B1); PG8_BAR; PG8_SCHED;
            } else {
            PG8_LDB(B0, 0, 0); PG8_SCHED; PG8_LDA(At, 0, 0); PG8_STAGE(PG8_SA(1, 1), a1 + hstep, voffA);
            PG8_WAIT_L(8); PG8_BAR; PG8_WAIT_L(0); PG8_MMA(0, 0, At, B0); PG8_BAR; PG8_SCHED;
            PG8_LDB(B1, 0, 1); PG8_STAGE(PG8_SB(0, 0), b2, voffB);
            PG8_BAR; PG8_WAIT_L(0); PG8_MMA(0, 1, At, B1); PG8_BAR;
            PG8_LDA(At, 0, 1); PG8_STAGE(PG8_SA(0, 0), a2, voffA);
            PG8_BAR; PG8_WAIT_L(0); PG8_MMA(1, 0, At, B0); PG8_BAR; PG8_SCHED;
            PG8_STAGE(PG8_SB(0, 1), b2 + hstep, voffB);
            PG8_WAIT_V(6); PG8_BAR; PG8_MMA(1, 1, At, B1); PG8_BAR;
            PG8_LDB(B0, 1, 0); PG8_SCHED; PG8_LDA(At, 1, 0); PG8_STAGE(PG8_SA(0, 1), a2 + hstep, voffA);
            PG8_WAIT_L(8); PG8_BAR; PG8_WAIT_L(0); PG8_MMA(0, 0, At, B0); PG8_BAR; PG8_SCHED;
            PG8_LDB(B1, 1, 1); PG8_STAGE(PG8_SB(1, 0), b3, voffB);
            PG8_BAR; PG8_WAIT_L(0); PG8_MMA(0, 1, At, B1); PG8_BAR;
            PG8_LDA(At, 1, 1); PG8_STAGE(PG8_SA(1, 0), a3, voffA);
            PG8_BAR; PG8_WAIT_L(0); PG8_MMA(1, 0, At, B0); PG8_BAR; PG8_SCHED;
            PG8_STAGE(PG8_SB(1, 1), b3 + hstep, voffB);
            PG8_WAIT_V(6); PG8_BAR; PG8_MMA(1, 1, At, B1); PG8_BAR;
            }
        }
        if constexpr (ALIGN_EPI) { if (wr == 0) PG8_BAR; }
        if constexpr (!Epi::AFTER_DRAIN) { E(acc, cur, wr, wc, fr, fq); S.done(cur); }
        if (!has_next) break;
#pragma unroll
        for (int a = 0; a < 2; ++a)
#pragma unroll
            for (int b = 0; b < 2; ++b)
#pragma unroll
                for (int m = 0; m < 4; ++m)
#pragma unroll
                    for (int n = 0; n < 2; ++n) acc[a][b][m][n] = (f32x4){0.f, 0.f, 0.f, 0.f};
        cur = nxt; cA = nA; cB = nB; ++ui;
        if constexpr (Epi::NARROW_PN >= 0) { const bool nar = (cur.pn == Epi::NARROW_PN); mma_on0 = !nar || (wc == 0); mma_on1 = !nar; }
        if constexpr (ALIGN_EPI) { if (wr == 1) PG8_BAR; }
    }
    PG8_WAIT_V(0);
    if constexpr (!ALIGN_EPI) { if (wr == 0) PG8_BAR; }
    PG8_BAR;
    if constexpr (Epi::AFTER_DRAIN) { E.fused(acc, cur, wr, wc, fr, fq, lds, wid, lane); S.done(cur); }
#undef PG8_SA
#undef PG8_SB
#undef PG8_STAGE
#undef PG8_LDA
#undef PG8_LDB
#undef PG8_MMA
#undef PG8_WAIT_V
#undef PG8_WAIT_L
#undef PG8_BAR
#undef PG8_SCHED
}
}

#define LAS __attribute__((address_space(3)))
#define DI __device__ __forceinline__
typedef unsigned short bf16;
typedef short bf16x8 __attribute__((ext_vector_type(8)));
typedef short s16x4 __attribute__((ext_vector_type(4)));
typedef float f32x4 __attribute__((ext_vector_type(4)));
typedef float f32x2 __attribute__((ext_vector_type(2)));
typedef unsigned u32x4 __attribute__((ext_vector_type(4)));
typedef unsigned u32x2 __attribute__((ext_vector_type(2)));
typedef __bf16 bf16v2 __attribute__((ext_vector_type(2)));
constexpr int NWAVES = 8, NTHR = 512;
constexpr int LDS_BYTES = 155648;

constexpr size_t MiB = 1u << 20;
constexpr size_t WS_CTL = 0, CTL_BYTES = 2 * MiB;
constexpr size_t WS_SSQ1 = 512 * 1024, WS_SSQ2 = 1024 * 1024;
constexpr size_t WS_WIN = 2 * MiB, WS_WNA = 13 * MiB, WS_WGLA = 14 * MiB, WS_WOUT = 15 * MiB, WS_WUP = 17 * MiB, WS_WDOWN = 25 * MiB, WS_BIAS = 33 * MiB;
constexpr size_t WS_U = 34 * MiB;
constexpr size_t WS_NAO = 162 * MiB, WS_GLAO = 226 * MiB;
constexpr size_t WS_PROJ = 290 * MiB;
constexpr size_t WS_END = 962 * MiB;

DI float bf2f(unsigned short b) { return __uint_as_float((unsigned)b << 16); }
DI unsigned pk2(float lo, float hi) { f32x2 v = {lo, hi}; bf16v2 b = __builtin_convertvector(v, bf16v2); return __builtin_bit_cast(unsigned, b); }
DI unsigned short f2bf(float x) { return (unsigned short)(pk2(x, 0.f) & 0xffffu); }
DI float wave_sum(float v) {
#pragma unroll
    for (int o = 1; o < 64; o <<= 1) v += __shfl_xor(v, o);
    return v;
}
#define LDS_WAIT() asm volatile("s_waitcnt lgkmcnt(0)" ::: "memory")
#define BAR_LDS() do { asm volatile("s_waitcnt lgkmcnt(0)" ::: "memory"); __builtin_amdgcn_s_barrier(); asm volatile("" ::: "memory"); } while (0)
#define MFMA32(a, b, c) __builtin_amdgcn_mfma_f32_16x16x32_bf16((a), (b), (c), 0, 0, 0)
#define MFMA16(a, b, c) __builtin_amdgcn_mfma_f32_16x16x16bf16_1k((a), (b), (c), 0, 0, 0)

struct Args {
    const float* x[2]; const float* norm_mix_g; const float* w_in; const float* b_in; const float* na_rpb;
    const float* gk_w[2]; const float* gk_b[2]; const float* gla_norm_g; const float* w_br_na; const float* w_br_gla; const float* w_out;
    const float* norm_mlp_g; const float* w_up; const float* w_down; const float* norm_final_g;
    float* out; unsigned char* ws; int ph_lo, ph_hi, coop, pad;
};

template <int MODE>
DI void transpose_item(const float* W, int K, int N, bf16* WT, LAS float* scr, int item, int lane, const float* g, int ldk = 0, int koff = 0) {
    if (ldk == 0) ldk = K;
    const int nblk = N / 32, kb = item / nblk, nb = item % nblk, k0 = 64 * kb, n0 = 32 * nb;
#pragma unroll 8
    for (int i = 0; i < 32; ++i) { const int kk = 2 * i + (lane >> 5); float v = W[(size_t)(k0 + kk) * N + n0 + (lane & 31)]; if (MODE == 2) v *= g[k0 + kk]; scr[kk * 33 + (lane & 31)] = v; }
    LDS_WAIT();
    int d0 = n0; if (MODE == 1) d0 = (n0 < 3072) ? n0 : ((n0 < 3104) ? (C_LR + (n0 - 3072)) : (n0 - 32));
    const int c = lane & 7;
#pragma unroll
    for (int j = 0; j < 4; ++j) { const int n = (lane >> 3) + 8 * j; const LAS float* s = scr + (8 * c) * 33 + n;
        u32x4 o; o.x = pk2(s[0 * 33], s[1 * 33]); o.y = pk2(s[2 * 33], s[3 * 33]); o.z = pk2(s[4 * 33], s[5 * 33]); o.w = pk2(s[6 * 33], s[7 * 33]);
        if (MODE == 3) *(u32x4*)(WT + ((((size_t)((d0 + n) >> 8) * (K / 64) + (k0 >> 6)) * 256 + ((d0 + n) & 255)) * 64 + 8 * c)) = o;
        else *(u32x4*)(WT + (size_t)(d0 + n) * ldk + koff + k0 + 8 * c) = o; }
    LDS_WAIT();
}
DI void rms_row2_to_bf16(const float* xrow0, const float* xrow1, const float* g, bf16* orow0, bf16* orow1, int lane) {
    const f32x4* xr0 = (const f32x4*)xrow0 + lane; const f32x4* xr1 = (const f32x4*)xrow1 + lane; const f32x4* gr = (const f32x4*)g + lane;
    f32x4 v0[4], v1[4]; float s0 = 0.f, s1 = 0.f;
#pragma unroll
    for (int j = 0; j < 4; ++j) { v0[j] = __builtin_nontemporal_load(xr0 + 64 * j); v1[j] = __builtin_nontemporal_load(xr1 + 64 * j); }
#pragma unroll
    for (int j = 0; j < 4; ++j) { s0 += (v0[j].x * v0[j].x + v0[j].y * v0[j].y) + (v0[j].z * v0[j].z + v0[j].w * v0[j].w); s1 += (v1[j].x * v1[j].x + v1[j].y * v1[j].y) + (v1[j].z * v1[j].z + v1[j].w * v1[j].w); }
    const float r0 = rsqrtf(wave_sum(s0) * (1.f / DM) + RMS_EPS), r1 = rsqrtf(wave_sum(s1) * (1.f / DM) + RMS_EPS);
    u32x2* o0 = (u32x2*)orow0 + lane; u32x2* o1 = (u32x2*)orow1 + lane;
#pragma unroll
    for (int j = 0; j < 4; ++j) { const f32x4 gg = gr[64 * j]; u32x2 w;
        w.x = pk2(v0[j].x * r0 * gg.x, v0[j].y * r0 * gg.y); w.y = pk2(v0[j].z * r0 * gg.z, v0[j].w * r0 * gg.w); o0[64 * j] = w;
        w.x = pk2(v1[j].x * r1 * gg.x, v1[j].y * r1 * gg.y); w.y = pk2(v1[j].z * r1 * gg.z, v1[j].w * r1 * gg.w); o1[64 * j] = w; }
}
DI void rms_row_to_bf16(const float* xrow, const float* g, bf16* orow, int lane) {
    const f32x4* xr = (const f32x4*)xrow + lane; const f32x4* gr = (const f32x4*)g + lane;
    f32x4 v[4]; float s = 0.f;
#pragma unroll
    for (int j = 0; j < 4; ++j) { v[j] = xr[64 * j]; s += (v[j].x * v[j].x + v[j].y * v[j].y) + (v[j].z * v[j].z + v[j].w * v[j].w); }
    const float rstd = rsqrtf(wave_sum(s) * (1.f / DM) + RMS_EPS);
    u32x2* o8 = (u32x2*)orow + lane;
#pragma unroll
    for (int j = 0; j < 4; ++j) { const f32x4 gg = gr[64 * j]; u32x2 w; w.x = pk2(v[j].x * rstd * gg.x, v[j].y * rstd * gg.y); w.y = pk2(v[j].z * rstd * gg.z, v[j].w * rstd * gg.w); o8[64 * j] = w; }
}
DI void final_row(float* row, const float* g, float ssq, int lane) {
    f32x4* xr = (f32x4*)row + lane; const f32x4* gr = (const f32x4*)g + lane;
    const float rstd = rsqrtf(ssq * (1.f / DM) + RMS_EPS);
#pragma unroll
    for (int j = 0; j < 4; ++j) { f32x4 v = xr[64 * j]; const f32x4 gg = gr[64 * j]; v = v * rstd; v = v * gg; xr[64 * j] = v; }
}

constexpr int GL_P = 144;
constexpr int GL_QD = 0, GL_KI = 9216, GL_KDT = 18432, GL_VT = 27648, GL_DEC = 46080, GL_LR = 47104, GL_CL = 51200, GL_OB = 52224, GL_OBP = 272, GL_DIR = 52224 + 64 * 272;
constexpr int GSEG = 1024;
DI float logsigmoid_(float x) { return fminf(x, 0.f) - __logf(1.0f + __expf(-fabsf(x))); }

DI void gla_pass1(LAS unsigned char* lds, const Args& A, const bf16* proj, bf16* scratch, bf16* QS, bf16* HT, float* DD, int T, int b, int h, int k, int tid_in) {
    int tid = tid_in; asm volatile("" : "+v"(tid));
    const int lane = tid & 63, wave = tid >> 6, dir = wave >> 2, c = wave & 3, d = lane, g = lane >> 4, l15 = lane & 15;
    LAS unsigned char* L = lds + dir * GL_DIR;
    constexpr int NI = GSEG / 64;
    const size_t rowb = (size_t)b * T + (size_t)k * GSEG;
    const int sidx = ((b * 4 + h) * (T / GSEG) + k) * 2 + dir;
    unsigned gkp[8];
#pragma unroll
    for (int j = 0; j < 8; ++j) gkp[j] = pk2(A.gk_w[dir][(2 * j) * 256 + h * 64 + d], A.gk_w[dir][(2 * j + 1) * 256 + h * 64 + d]);
    const float gkb = A.gk_b[dir][h * 64 + d];
    f32x4 S[4][2];
#pragma unroll
    for (int mt = 0; mt < 4; ++mt)
#pragma unroll
        for (int nt = 0; nt < 2; ++nt) S[mt][nt] = (f32x4){0.f, 0.f, 0.f, 0.f};
    const int vs = c * 32;
    const int tl = tid & 255;
    float carry = 0.f;
    unsigned short qraw[16], kraw[16]; u32x2 lrraw; u32x4 vraw[4];
#define GLA_ROW(s) (rowb + (size_t)(dir ? (GSEG - 1 - (s)) : (s)))
#define GLA_PREFETCH(it) do { const int s0_ = (it) * 64; \
        _Pragma("unroll") for (int i = 0; i < 16; ++i) { const bf16* p_ = proj + GLA_ROW(s0_ + c * 16 + i) * NP + h * 64 + d; qraw[i] = p_[C_GQ]; kraw[i] = p_[C_GK]; } \
        lrraw = *(const u32x2*)(proj + GLA_ROW(s0_ + c * 16 + (lane >> 2)) * NP + C_LR + dir * 16 + (lane & 3) * 4); \
        _Pragma("unroll") for (int q = 0; q < 4; ++q) { const int idx_ = tl + 256 * q; vraw[q] = *(const u32x4*)(proj + GLA_ROW(s0_ + (idx_ & 63)) * NP + C_GV + h * 128 + (idx_ >> 6) * 8); } } while (0)
#define GLA_FLUSH(itf) do { _Pragma("unroll") for (int q_ = 0; q_ < 4; ++q_) { const int idx_ = tl + 256 * q_, tk_ = idx_ >> 4, ch_ = idx_ & 15; \
        *(u32x4*)(scratch + GLA_ROW((itf) * 64 + tk_) * DM + dir * 512 + h * 128 + ch_ * 8) = *(const LAS u32x4*)(L + GL_OB + tk_ * GL_OBP + ch_ * 16); } } while (0)
    GLA_PREFETCH(0);
#pragma unroll 1
    for (int it = 0; it < NI; ++it) {
        BAR_LDS();
        if (it > 0) GLA_FLUSH(it - 1);
        *(LAS u32x2*)(L + GL_LR + (c * 16 + (lane >> 2)) * 32 + (lane & 3) * 8) = lrraw;
        LDS_WAIT();
        float qdv[16];
        {   float cum = 0.f; float kinv[16];
#pragma unroll
            for (int i = 0; i < 16; ++i) {
                const LAS u32x4* lr4 = (const LAS u32x4*)(L + GL_LR + (c * 16 + i) * 32);
                const u32x4 la_ = lr4[0], lb_ = lr4[1];
                const unsigned lw[8] = {la_.x, la_.y, la_.z, la_.w, lb_.x, lb_.y, lb_.z, lb_.w};
                float pre = gkb;
#pragma unroll
                for (int j = 0; j < 8; ++j) pre = __builtin_amdgcn_fdot2_f32_bf16(__builtin_bit_cast(bf16v2, lw[j]), __builtin_bit_cast(bf16v2, gkp[j]), pre, false);
                cum += logsigmoid_(pre) * (1.0f / 16.0f);
                const float e = __expf(cum); qdv[i] = bf2f(qraw[i]) * e;
                kinv[i] = bf2f(kraw[i]) * __builtin_amdgcn_rcpf(e);
                *(LAS unsigned short*)(L + GL_QD + (c * 16 + i) * GL_P + d * 2) = f2bf(qdv[i]);
                *(LAS unsigned short*)(L + GL_KI + (c * 16 + i) * GL_P + d * 2) = f2bf(kinv[i]);
            }
            const float eL = __expf(cum);
            ((LAS float*)(L + GL_DEC))[c * 64 + d] = eL;
            ((LAS float*)(L + GL_CL))[c * 64 + d] = cum;
            u32x4 w0, w1;
            w0.x = pk2(kinv[0] * eL, kinv[1] * eL); w0.y = pk2(kinv[2] * eL, kinv[3] * eL); w0.z = pk2(kinv[4] * eL, kinv[5] * eL); w0.w = pk2(kinv[6] * eL, kinv[7] * eL);
            w1.x = pk2(kinv[8] * eL, kinv[9] * eL); w1.y = pk2(kinv[10] * eL, kinv[11] * eL); w1.z = pk2(kinv[12] * eL, kinv[13] * eL); w1.w = pk2(kinv[14] * eL, kinv[15] * eL);
            *(LAS u32x4*)(L + GL_KDT + d * GL_P + c * 32) = w0; *(LAS u32x4*)(L + GL_KDT + d * GL_P + c * 32 + 16) = w1;
        }
#pragma unroll
        for (int q = 0; q < 4; ++q) { const int idx = tl + 256 * q, tk = idx & 63, v0 = (idx >> 6) * 8;
#pragma unroll
            for (int e = 0; e < 8; ++e) { const unsigned w = vraw[q][e >> 1]; *(LAS unsigned short*)(L + GL_VT + (v0 + e) * GL_P + tk * 2) = (unsigned short)((e & 1) ? (w >> 16) : (w & 0xffffu)); } }
        BAR_LDS();
        {   const LAS float* CL = (const LAS float*)(L + GL_CL) + d; const float c0 = CL[0], c1 = CL[64], c2 = CL[128], c3 = CL[192];
            const float off = carry + ((c > 0) ? c0 : 0.f) + ((c > 1) ? c1 : 0.f) + ((c > 2) ? c2 : 0.f);
            carry += (c0 + c1) + (c2 + c3);
            const float eo = __expf(off);
#pragma unroll
            for (int i = 0; i < 16; ++i) QS[GLA_ROW(it * 64 + c * 16 + i) * 512 + dir * 256 + h * 64 + d] = f2bf(qdv[i] * eo); }
#pragma unroll
        for (int cc = 0; cc < 4; ++cc) {
            const int trow = cc * 16 + l15;
            f32x4 X = (f32x4){0.f, 0.f, 0.f, 0.f};
#pragma unroll
            for (int ks = 0; ks < 2; ++ks) { const bf16x8 ki = *(const LAS bf16x8*)(L + GL_KI + trow * GL_P + (ks * 32 + 8 * g) * 2), qd = *(const LAS bf16x8*)(L + GL_QD + trow * GL_P + (ks * 32 + 8 * g) * 2);
                X = MFMA32(ki, qd, X); }
#pragma unroll
            for (int r = 0; r < 4; ++r) if (4 * g + r > l15) X[r] = 0.f;
            u32x2 pp; pp.x = pk2(X[0], X[1]); pp.y = pk2(X[2], X[3]);
            const s16x4 P = __builtin_bit_cast(s16x4, pp);
            s16x4 vt[2]; f32x4 o[2];
#pragma unroll
            for (int nt = 0; nt < 2; ++nt) { vt[nt] = *(const LAS s16x4*)(L + GL_VT + (vs + 16 * nt + l15) * GL_P + (cc * 16 + 4 * g) * 2);
                o[nt] = MFMA16(P, vt[nt], ((f32x4){0.f, 0.f, 0.f, 0.f})); }
#pragma unroll
            for (int ks = 0; ks < 2; ++ks) {
                const u32x2 qlo = *(const LAS u32x2*)(L + GL_QD + trow * GL_P + (32 * ks + 4 * g) * 2), qhi = *(const LAS u32x2*)(L + GL_QD + trow * GL_P + (32 * ks + 16 + 4 * g) * 2);
                const u32x4 qq = (u32x4){qlo.x, qlo.y, qhi.x, qhi.y}; const bf16x8 qa = __builtin_bit_cast(bf16x8, qq);
#pragma unroll
                for (int nt = 0; nt < 2; ++nt) { const f32x4 s0 = S[2 * ks][nt], s1 = S[2 * ks + 1][nt];
                    const u32x4 sw = (u32x4){pk2(s0[0], s0[1]), pk2(s0[2], s0[3]), pk2(s1[0], s1[1]), pk2(s1[2], s1[3])};
                    o[nt] = MFMA32(qa, __builtin_bit_cast(bf16x8, sw), o[nt]); } }
#pragma unroll
            for (int r = 0; r < 4; ++r) { LAS unsigned short* op = (LAS unsigned short*)(L + GL_OB + (cc * 16 + 4 * g + r) * GL_OBP + (vs + l15) * 2); op[0] = f2bf(o[0][r]); op[16] = f2bf(o[1][r]); }
#pragma unroll
            for (int mt = 0; mt < 4; ++mt) { const f32x4 dec = *(const LAS f32x4*)(L + GL_DEC + (cc * 64 + 16 * mt + 4 * g) * 4);
                const s16x4 kd = *(const LAS s16x4*)(L + GL_KDT + (16 * mt + l15) * GL_P + (cc * 16 + 4 * g) * 2);
#pragma unroll
                for (int nt = 0; nt < 2; ++nt) { f32x4 sv = S[mt][nt]; sv = sv * dec; S[mt][nt] = MFMA16(kd, vt[nt], sv); } }
            if (cc == 1 && it + 1 < NI) GLA_PREFETCH(it + 1);
        }
    }
    BAR_LDS();
    GLA_FLUSH(NI - 1);
#undef GLA_FLUSH
#undef GLA_PREFETCH
#undef GLA_ROW
#pragma unroll
    for (int mt = 0; mt < 4; ++mt)
#pragma unroll
        for (int nt = 0; nt < 2; ++nt) { u32x2 w; w.x = pk2(S[mt][nt][0], S[mt][nt][1]); w.y = pk2(S[mt][nt][2], S[mt][nt][3]);
            *(u32x2*)(HT + ((size_t)sidx * 128 + vs + 16 * nt + l15) * 64 + 16 * mt + 4 * g) = w; }
    if (c == 0) DD[(size_t)sidx * 64 + d] = __expf(carry);
    __syncthreads();
}

constexpr int G2_S0 = 0, G2_OT = 36864, G2_OTP = 132;
DI void gla_pass2(LAS unsigned char* lds, const Args& A, const bf16* proj, const bf16* scratch, const bf16* QS, const bf16* HT, const float* DD, bf16* glao, int T, int b, int h, int k, int tid_in) {
    int tid = tid_in; asm volatile("" : "+v"(tid));
    const int lane = tid & 63, wave = tid >> 6, g = lane >> 4, l15 = lane & 15;
    const int nseg = T / GSEG;
    const size_t rowb = (size_t)b * T + (size_t)k * GSEG;
    const int ntk = tid >> 3, nvc = tid & 7;
    bf16x8 AF[4][2][2]; u32x4 SC[2][2]; u32x4 gw[2];
#define G2_LOAD(grp) do { _Pragma("unroll") for (int mt_ = 0; mt_ < 4; ++mt_) { const size_t r0_ = rowb + (grp) * 64 + mt_ * 16; \
        _Pragma("unroll") for (int dir_ = 0; dir_ < 2; ++dir_) _Pragma("unroll") for (int ks_ = 0; ks_ < 2; ++ks_) AF[mt_][dir_][ks_] = *(const bf16x8*)(QS + (r0_ + l15) * 512 + dir_ * 256 + h * 64 + ks_ * 32 + 8 * g); \
        } \
        { const u32x4* gp_ = (const u32x4*)(proj + (rowb + (grp) * 64 + ntk) * NP + C_GG + h * 128 + nvc * 16); gw[0] = gp_[0]; gw[1] = gp_[1]; \
          const u32x4* sp_ = (const u32x4*)(scratch + (rowb + (grp) * 64 + ntk) * DM + h * 128 + nvc * 16); SC[0][0] = sp_[0]; SC[0][1] = sp_[1]; SC[1][0] = sp_[64]; SC[1][1] = sp_[65]; } } while (0)
    G2_LOAD(0);
    {   const int dir = tid >> 8, oct = tid & 7, vq = (tid & 255) >> 3;
        float acc[4][8], w[8];
#pragma unroll
        for (int e = 0; e < 8; ++e) { w[e] = 1.f;
#pragma unroll
            for (int j = 0; j < 4; ++j) acc[j][e] = 0.f; }
        const int nsteps = dir ? (nseg - 1 - k) : k;
        const int sbase = ((b * 4 + h) * nseg) * 2 + dir, mstep = dir ? 2 : -2;
        int si = sbase + 2 * (dir ? (k + 1) : (k - 1));
        u32x4 hc[4]; f32x4 dc[2];
#define G2_LDH(sidx, hh, dd) do { _Pragma("unroll") for (int j_ = 0; j_ < 4; ++j_) hh[j_] = *(const u32x4*)(HT + ((size_t)(sidx) * 128 + vq + 32 * j_) * 64 + oct * 8); \
        dd[0] = *(const f32x4*)(DD + (size_t)(sidx) * 64 + oct * 8); dd[1] = *(const f32x4*)(DD + (size_t)(sidx) * 64 + oct * 8 + 4); } while (0)
        if (nsteps > 0) G2_LDH(si, hc, dc);
#pragma unroll 1
        for (int st = 0; st < nsteps; ++st) {
            u32x4 hn[4]; f32x4 dn[2];
#pragma unroll
            for (int j = 0; j < 4; ++j) hn[j] = hc[j];
            dn[0] = dc[0]; dn[1] = dc[1];
            si += mstep;
            if (st + 1 < nsteps) G2_LDH(si, hn, dn);
#pragma unroll
            for (int j = 0; j < 4; ++j)
#pragma unroll
                for (int e = 0; e < 8; ++e) { const unsigned x = hc[j][e >> 1]; const float hv = (e & 1) ? __uint_as_float(x & 0xffff0000u) : __uint_as_float(x << 16); acc[j][e] += w[e] * hv; }
#pragma unroll
            for (int e = 0; e < 8; ++e) w[e] *= (e < 4) ? dc[0][e & 3] : dc[1][e & 3];
#pragma unroll
            for (int j = 0; j < 4; ++j) hc[j] = hn[j];
            dc[0] = dn[0]; dc[1] = dn[1];
        }
#undef G2_LDH
#pragma unroll
        for (int j = 0; j < 4; ++j) *(LAS u32x4*)(lds + G2_S0 + dir * 18432 + (vq + 32 * j) * GL_P + oct * 16) =
            (u32x4){pk2(acc[j][0], acc[j][1]), pk2(acc[j][2], acc[j][3]), pk2(acc[j][4], acc[j][5]), pk2(acc[j][6], acc[j][7])};
    }
    BAR_LDS();
    bf16x8 Bf[2][2];
#pragma unroll
    for (int dir = 0; dir < 2; ++dir)
#pragma unroll
        for (int ks = 0; ks < 2; ++ks) Bf[dir][ks] = *(const LAS bf16x8*)(lds + G2_S0 + dir * 18432 + (16 * wave + l15) * GL_P + (ks * 32 + 8 * g) * 2);
    LAS float* OT = (LAS float*)(lds + G2_OT);
    f32x4 gn[4];
#pragma unroll
    for (int j = 0; j < 4; ++j) gn[j] = *(const f32x4*)(A.gla_norm_g + nvc * 16 + 4 * j);
#pragma unroll 1
    for (int grp = 0; grp < GSEG / 64; ++grp) {
#pragma unroll
        for (int mtile = 0; mtile < 4; ++mtile) {
            f32x4 acc = (f32x4){0.f, 0.f, 0.f, 0.f};
#pragma unroll
            for (int dir = 0; dir < 2; ++dir)
#pragma unroll
                for (int ks = 0; ks < 2; ++ks) acc = MFMA32(AF[mtile][dir][ks], Bf[dir][ks], acc);
#pragma unroll
            for (int r = 0; r < 4; ++r) OT[(mtile * 16 + 4 * g + r) * G2_OTP + 16 * wave + l15] = acc[r];
        }
        const u32x4 gw0 = gw[0], gw1 = gw[1], sf0 = SC[0][0], sf1 = SC[0][1], sb0 = SC[1][0], sb1 = SC[1][1];
        if (grp + 1 < GSEG / 64) G2_LOAD(grp + 1);
        BAR_LDS();
        {   const size_t row = rowb + grp * 64 + ntk; f32x4 sv[4]; float ss = 0.f;
#pragma unroll
            for (int j = 0; j < 4; ++j) { const u32x4 cf = (j < 2) ? sf0 : sf1, cb = (j < 2) ? sb0 : sb1; const unsigned f0 = cf[2 * (j & 1)], f1 = cf[2 * (j & 1) + 1], b0 = cb[2 * (j & 1)], b1 = cb[2 * (j & 1) + 1];
                f32x4 lo; lo.x = __uint_as_float(f0 << 16) + __uint_as_float(b0 << 16); lo.y = __uint_as_float(f0 & 0xffff0000u) + __uint_as_float(b0 & 0xffff0000u);
                lo.z = __uint_as_float(f1 << 16) + __uint_as_float(b1 << 16); lo.w = __uint_as_float(f1 & 0xffff0000u) + __uint_as_float(b1 & 0xffff0000u);
                sv[j] = *(const LAS f32x4*)(OT + ntk * G2_OTP + nvc * 16 + 4 * j) + lo; ss += (sv[j].x * sv[j].x + sv[j].y * sv[j].y) + (sv[j].z * sv[j].z + sv[j].w * sv[j].w); }
            ss += __shfl_xor(ss, 1); ss += __shfl_xor(ss, 2); ss += __shfl_xor(ss, 4);
            const float rstd = rsqrtf(ss * (1.0f / 128.0f) + RMS_EPS);
            u32x4* op = (u32x4*)(glao + row * DM + h * 128 + nvc * 16);
#pragma unroll
            for (int j2 = 0; j2 < 2; ++j2) { const u32x4 gq = j2 ? gw1 : gw0; const f32x4 a = sv[2 * j2] * rstd * gn[2 * j2], bb = sv[2 * j2 + 1] * rstd * gn[2 * j2 + 1];
                u32x4 w;
                w.x = pk2(a.x * __uint_as_float(gq.x << 16), a.y * __uint_as_float(gq.x & 0xffff0000u)); w.y = pk2(a.z * __uint_as_float(gq.y << 16), a.w * __uint_as_float(gq.y & 0xffff0000u));
                w.z = pk2(bb.x * __uint_as_float(gq.z << 16), bb.y * __uint_as_float(gq.z & 0xffff0000u)); w.w = pk2(bb.z * __uint_as_float(gq.w << 16), bb.w * __uint_as_float(gq.w & 0xffff0000u));
                op[j2] = w; }
        }
        BAR_LDS();
    }
#undef G2_LOAD
}

constexpr int NA_K = 0, NA_V = 65536, NA_MRG = 131072, NA_BIAS = 131072 + 18432, NA_ITEM = NA_BIAS + 1920;
static_assert(NA_ITEM + 64 <= LDS_BYTES, "NA LDS map");
DI void na_phase(LAS unsigned char* lds, const Args& A, const bf16* proj, bf16* nao, int T, int nB, unsigned* counter, int tid_in) {
    int tid = tid_in; asm volatile("" : "+v"(tid));
    const int lane = tid & 63, wave = tid >> 6, qg = wave & 3, kh = wave >> 2, g = lane >> 4, l15 = lane & 15;
    constexpr int NAR = 32;
    const int rows = T / 64, nr = rows / NAR, nitems = nB * 8 * nr;
    const int cq = 16 * qg + l15;
    const int cs0 = (qg == 0) ? 0 : ((qg == 1) ? 8 : ((qg == 2) ? 24 : 32));
    const int csq = min(max(cq - 8, 0), 48);
    const int lc = tid >> 3, lc8 = tid & 7;
    for (;;) {
        if (tid == 0) *(LAS unsigned*)(lds + NA_ITEM) = atomicAdd(counter, 1u);
        __syncthreads();
        const int item = (int)*(LAS unsigned*)(lds + NA_ITEM);
        if (item >= nitems) break;
        const int b = item / (8 * nr), h = (item / nr) & 7, r0 = (item % nr) * NAR;
        const size_t rowb = (size_t)b * T;
        if (tid < 465) ((LAS float*)(lds + NA_BIAS))[tid] = A.na_rpb[h * 465 + tid];
#define NA_RS(r) min(max((r) - 4, 0), rows - 8)
#define NA_LOADROW(kr, kreg, vreg) do { const bf16* p_ = proj + (rowb + (size_t)(kr) * 64 + lc) * NP + h * 64 + lc8 * 8; kreg = *(const u32x4*)(p_ + C_NAK); vreg = *(const u32x4*)(p_ + C_NAV); } while (0)
#define NA_STOREROW(kr, kreg, vreg) do { const int sl_ = (kr) & 7; \
            *(LAS u32x4*)(lds + NA_K + sl_ * 8192 + lc * 128 + ((lc8 ^ ((lc >> 1) & 7)) * 16)) = kreg; \
            _Pragma("unroll") for (int e = 0; e < 8; ++e) { const int d_ = lc8 * 8 + e; const unsigned w_ = vreg[e >> 1]; \
                *(LAS unsigned short*)(lds + NA_V + sl_ * 8192 + d_ * 128 + (((lc >> 2) ^ (2 * ((d_ >> 1) & 7))) * 8) + (lc & 3) * 2) = (unsigned short)((e & 1) ? (w_ >> 16) : (w_ & 0xffffu)); } } while (0)
        {   const int rs0 = NA_RS(r0); u32x4 kr8[8], vr8[8];
#pragma unroll
            for (int i = 0; i < 8; ++i) NA_LOADROW(rs0 + i, kr8[i], vr8[i]);
#pragma unroll
            for (int i = 0; i < 8; ++i) NA_STOREROW(rs0 + i, kr8[i], vr8[i]); }
        bf16x8 qf[2], qn[2];
#define NA_LOADQ(r, dst) do { const bf16* p_ = proj + (rowb + (size_t)(r) * 64 + cq) * NP + C_NAQ + h * 64 + 8 * g; dst[0] = *(const bf16x8*)p_; dst[1] = *(const bf16x8*)(p_ + 32); } while (0)
        NA_LOADQ(r0, qf);
        __syncthreads();
#pragma unroll 1
        for (int r = r0; r < r0 + NAR; ++r) {
            const int rs = NA_RS(r);
            const bool more = (r + 1 < r0 + NAR), need_new = more && (NA_RS(r + 1) != rs);
            u32x4 kreg = (u32x4){0u, 0u, 0u, 0u}, vreg = (u32x4){0u, 0u, 0u, 0u};
            if (need_new) NA_LOADROW(rs + 8, kreg, vreg);
            if (more) NA_LOADQ(r + 1, qn);
            f32x4 sT[4][2]; float mx = -INFINITY;
            const LAS float* BI = (const LAS float*)(lds + NA_BIAS);
#pragma unroll
            for (int rr = 0; rr < 4; ++rr) { const int kr = rs + 4 * kh + rr, sl = kr & 7;
#pragma unroll
                for (int ct = 0; ct < 2; ++ct) { const int cm = cs0 + 16 * ct + l15; f32x4 acc = (f32x4){0.f, 0.f, 0.f, 0.f};
#pragma unroll
                    for (int ks = 0; ks < 2; ++ks) { const bf16x8 kf = *(const LAS bf16x8*)(lds + NA_K + sl * 8192 + cm * 128 + (((4 * ks + g) ^ ((cm >> 1) & 7)) * 16)); acc = MFMA32(kf, qf[ks], acc); }
#pragma unroll
                    for (int e = 0; e < 4; ++e) { const int cc = cs0 + 16 * ct + 4 * g + e; const bool valid = (cc >= csq) && (cc < csq + 16);
                        const int bi = (kr - r + 7) * 31 + min(max(cc - cq + 15, 0), 30);
                        const float sv = valid ? acc[e] + BI[bi] : -INFINITY; acc[e] = sv; mx = fmaxf(mx, sv); }
                    sT[rr][ct] = acc; } }
            mx = fmaxf(mx, __shfl_xor(mx, 16)); mx = fmaxf(mx, __shfl_xor(mx, 32));
            float lsum = 0.f;
#pragma unroll
            for (int rr = 0; rr < 4; ++rr)
#pragma unroll
                for (int ct = 0; ct < 2; ++ct)
#pragma unroll
                    for (int e = 0; e < 4; ++e) { const float p = __expf(sT[rr][ct][e] - mx); sT[rr][ct][e] = p; lsum += p; }
            lsum += __shfl_xor(lsum, 16); lsum += __shfl_xor(lsum, 32);
            f32x4 O[4];
#pragma unroll
            for (int mt = 0; mt < 4; ++mt) O[mt] = (f32x4){0.f, 0.f, 0.f, 0.f};
#pragma unroll
            for (int rr = 0; rr < 4; ++rr) { const int sl = (rs + 4 * kh + rr) & 7;
                const u32x4 pw = (u32x4){pk2(sT[rr][0][0], sT[rr][0][1]), pk2(sT[rr][0][2], sT[rr][0][3]), pk2(sT[rr][1][0], sT[rr][1][1]), pk2(sT[rr][1][2], sT[rr][1][3])};
                const bf16x8 pb = __builtin_bit_cast(bf16x8, pw);
#pragma unroll
                for (int mt = 0; mt < 4; ++mt) { const int dd = 16 * mt + l15, sw = 2 * ((dd >> 1) & 7);
                    const LAS unsigned char* vb = lds + NA_V + sl * 8192 + dd * 128;
                    const u32x2 lo = *(const LAS u32x2*)(vb + ((((cs0 >> 2) + g) ^ sw) * 8)), hi = *(const LAS u32x2*)(vb + ((((cs0 >> 2) + 4 + g) ^ sw) * 8));
                    const u32x4 vv = (u32x4){lo.x, lo.y, hi.x, hi.y};
                    O[mt] = MFMA32(__builtin_bit_cast(bf16x8, vv), pb, O[mt]); } }
            LAS float* MG = (LAS float*)(lds + NA_MRG + qg * 4608) + lane;
            if (kh == 1) { MG[0] = mx; MG[64] = lsum;
#pragma unroll
                for (int mt = 0; mt < 4; ++mt)
#pragma unroll
                    for (int e = 0; e < 4; ++e) MG[(2 + mt * 4 + e) * 64] = O[mt][e]; }
            __syncthreads();
            if (kh == 0) { const float m1 = MG[0], l1 = MG[64], M = fmaxf(mx, m1), a0 = __expf(mx - M), a1 = __expf(m1 - M), inv = 1.0f / (lsum * a0 + l1 * a1);
                bf16* op = nao + (rowb + (size_t)r * 64 + cq) * DM + h * 64 + 4 * g;
#pragma unroll
                for (int mt = 0; mt < 4; ++mt) { float v[4];
#pragma unroll
                    for (int e = 0; e < 4; ++e) v[e] = (O[mt][e] * a0 + MG[(2 + mt * 4 + e) * 64] * a1) * inv;
                    u32x2 w; w.x = pk2(v[0], v[1]); w.y = pk2(v[2], v[3]); *(u32x2*)(op + 16 * mt) = w; } }
            if (need_new) NA_STOREROW(rs + 8, kreg, vreg);
            if (more) { qf[0] = qn[0]; qf[1] = qn[1]; }
            __syncthreads();
        }
#undef NA_RS
#undef NA_LOADROW
#undef NA_STOREROW
#undef NA_LOADQ
    }
    __syncthreads();
}

#define XB_TMO      128
#define XB_XCNT(j)  (256  + 64 * (j))
#define XB_XSUB(j)  (1280 + 64 * (j))
#define XB_XGEN(j)  (2304 + 64 * (j))
#define XB_TOP      3328
#define XB_TOPGEN   3392
#define XCD_BAR_WORDS 3456
#define XB_SPIN_CAP (1u << 18)

__device__ __forceinline__ unsigned xb_ld(unsigned* p)              { return __hip_atomic_load(p, __ATOMIC_RELAXED, __HIP_MEMORY_SCOPE_AGENT); }
__device__ __forceinline__ unsigned xb_add(unsigned* p, unsigned v) { return __hip_atomic_fetch_add(p, v, __ATOMIC_RELAXED, __HIP_MEMORY_SCOPE_AGENT); }
__device__ __forceinline__ unsigned xb_xcc_id() { return (unsigned)__builtin_amdgcn_s_getreg((3 << 11) | 20) & 0xFu; }
#define XB_SPIN(cond, bar) do { unsigned _sp = 0; while (cond) { __builtin_amdgcn_s_sleep(1); \
    if ((++_sp & 255u) == 0u) { if (xb_ld(&(bar)[XB_TMO])) break; if (_sp > XB_SPIN_CAP) { atomicAdd(&(bar)[XB_TMO], 1u); break; } } } } while (0)

struct XcdBarrier {
    unsigned* bar; unsigned x;
    volatile LAS unsigned* st;
};

__device__ __forceinline__ XcdBarrier xcd_barrier_post(unsigned* bar, volatile LAS unsigned* st) {
    XcdBarrier b; b.bar = bar; b.x = xb_xcc_id(); b.st = st;
    if (threadIdx.x == 0) (void)xb_add(&bar[XB_XCNT(b.x)], 1u);
    return b;
}
__device__ __forceinline__ void xcd_barrier_complete(unsigned* bar, unsigned x, unsigned& nloc, unsigned& nx) {
    const unsigned G = gridDim.x * gridDim.y * gridDim.z;
    unsigned sum, cnt, mine, sp = 0u;
    for (;;) {
        sum = 0u; cnt = 0u; mine = 0u;
#pragma unroll
        for (unsigned j = 0; j < 16; ++j) { const unsigned c = xb_ld(&bar[XB_XCNT(j)]); sum += c; cnt += (c > 0u) ? 1u : 0u; mine = (j == x) ? c : mine; }
        if (sum == G) break;
        __builtin_amdgcn_s_sleep(1);
        if ((++sp & 255u) == 0u) { if (xb_ld(&bar[XB_TMO])) break; if (sp > XB_SPIN_CAP) { atomicAdd(&bar[XB_TMO], 1u); break; } }
    }
    nloc = mine > 0u ? mine : 1u; nx = cnt > 0u ? cnt : 1u;
}

__device__ __forceinline__ void xcd_barrier(const XcdBarrier& b) {
    asm volatile("s_waitcnt vmcnt(0)" ::: "memory");
    __syncthreads();
    if (threadIdx.x == 0) {
        unsigned* bar = b.bar;
        __builtin_amdgcn_s_waitcnt(0);
        unsigned nloc = b.st[0], nx = b.st[1];
        if (nloc == 0u) { xcd_barrier_complete(bar, b.x, nloc, nx); b.st[0] = nloc; b.st[1] = nx; }
        const unsigned old = xb_add(&bar[XB_XSUB(b.x)], 1u);
        const unsigned gen = old / nloc;
        if (old + 1u == (gen + 1u) * nloc) {
            __builtin_amdgcn_fence(__ATOMIC_RELEASE, "agent");
            asm volatile("s_waitcnt vmcnt(0)" ::: "memory");
            const unsigned og = xb_add(&bar[XB_TOP], 1u);
            const unsigned tg = og / nx;
            if (og + 1u == (tg + 1u) * nx) xb_add(&bar[XB_TOPGEN], 1u);
            else XB_SPIN(xb_ld(&bar[XB_TOPGEN]) == tg, bar);
            __builtin_amdgcn_fence(__ATOMIC_ACQUIRE, "agent");
            xb_add(&bar[XB_XGEN(b.x)], 1u);
            asm volatile("s_waitcnt vmcnt(0)" ::: "memory");
        } else {
            XB_SPIN(xb_ld(&bar[XB_XGEN(b.x)]) == gen, bar);
            __builtin_amdgcn_fence(__ATOMIC_ACQUIRE, "agent");
            asm volatile("s_waitcnt vmcnt(0)" ::: "memory");
        }
    }
    __syncthreads();
}

constexpr int N_PHASES = 15;
__global__ void __launch_bounds__(NTHR, 2) fwd_kernel(Args A) {
    extern __shared__ __attribute__((aligned(16))) unsigned char lds_raw[];
    LAS unsigned char* lds = (LAS unsigned char*)lds_raw;
    const int tid = threadIdx.x, lane = tid & 63, wave = __builtin_amdgcn_readfirstlane(tid >> 6);
    const int G = gridDim.x, bx = blockIdx.x;
    unsigned char* ws = A.ws;
#define Wt_in ((bf16*)(ws + WS_WIN))
#define Wt_na ((bf16*)(ws + WS_WNA))
#define Wt_gla ((bf16*)(ws + WS_WGLA))
#define Wt_out ((bf16*)(ws + WS_WOUT))
#define Wt_up ((bf16*)(ws + WS_WUP))
#define Wt_down ((bf16*)(ws + WS_WDOWN))
#define biasp ((float*)(ws + WS_BIAS))
#define U ((bf16*)(ws + WS_U))
#define NAO ((bf16*)(ws + WS_NAO))
#define GLAO ((bf16*)(ws + WS_NAO) + 512)
#define HB ((bf16*)(ws + WS_NAO))
#define PROJ ((bf16*)(ws + WS_PROJ))
#define HDN ((bf16*)(ws + WS_PROJ))
#define ctl ((unsigned*)(ws + WS_CTL))
    const int gw = bx * NWAVES + wave, NGW = G * NWAVES;
    const int lo = A.ph_lo, hi = A.ph_hi;
#ifndef PH_MASK
#define PH_MASK 0x1ff
#endif
#define PHM(b) ((PH_MASK >> (b)) & 1)
#define IN(k) (lo <= (k) && (k) < hi)
    if (tid < 2) ((volatile LAS unsigned*)(lds + LDS_BYTES - 64))[tid] = 0u;
    __syncthreads();
    XcdBarrier xbar; xbar.bar = ctl + 4096; xbar.x = 0; xbar.st = nullptr;
    if (A.coop) xbar = xcd_barrier_post(ctl + 4096, (volatile LAS unsigned*)(lds + LDS_BYTES - 64));
#define SEAM(k) do { if (IN(k) && IN((k) + 1)) { if ((k) == 0) cg::this_grid().sync(); else xcd_barrier(xbar); } } while (0)

    if (PHM(0) && IN(0)) {
        LAS float* scr = (LAS float*)(lds + wave * 16384);
        constexpr int I_IN = (DM / 64) * (5152 / 32), I_BR = (512 / 64) * (DM / 32), I_OUT = (DM / 64) * (DM / 32), I_UP = (DM / 64) * (DFF / 32), I_DN = (DFF / 64) * (DM / 32);
        constexpr int NITEMS = I_IN + 2 * I_BR + I_OUT + I_UP + I_DN;
        for (int pass = 0; pass < 2; ++pass) {
        if ((pass ^ (wave & 1)) == 0) {
        for (int it = gw; it < NITEMS; it += NGW) {
            int r = it;
            if (r < I_IN) { transpose_item<1>(A.w_in, DM, 5152, Wt_in, scr, r, lane, nullptr); continue; } r -= I_IN;
            if (r < I_BR) { transpose_item<0>(A.w_br_na, 512, DM, Wt_na, scr, r, lane, nullptr, DM, 0); continue; } r -= I_BR;
            if (r < I_BR) { transpose_item<0>(A.w_br_gla, 512, DM, Wt_na, scr, r, lane, nullptr, DM, 512); continue; } r -= I_BR;
            if (r < I_OUT) { transpose_item<0>(A.w_out, DM, DM, Wt_out, scr, r, lane, nullptr); continue; } r -= I_OUT;
            if (r < I_UP) { transpose_item<2>(A.w_up, DM, DFF, Wt_up, scr, r, lane, A.norm_mlp_g); continue; } r -= I_UP;
            transpose_item<3>(A.w_down, DFF, DM, Wt_down, scr, r, lane, nullptr);
        }
        } else {
        for (int m = gw; m < SBTOK; m += NGW) rms_row2_to_bf16(A.x[0] + (size_t)m * DM, A.x[1] + (size_t)m * DM, A.norm_mix_g, U + (size_t)m * DM, (bf16*)(A.out + (size_t)SBTOK * DM) + (size_t)m * DM, lane);
        }
        }
        {   const int gt = bx * NTHR + tid, NGT = G * NTHR;
            u32x4* zp = (u32x4*)(Wt_in + (size_t)5152 * DM);
            for (int i = gt; i < 224 * DM * 2 / 16; i += NGT) zp[i] = (u32x4){0u, 0u, 0u, 0u};
            for (int n = gt; n < NP; n += NGT) { float v = 0.f; if (n < 3072) v = A.b_in[n]; else if (n < C_LR) v = A.b_in[n + 32]; else if (n < C_LR + 32) v = A.b_in[3072 + (n - C_LR)]; biasp[n] = v; } }
        __syncthreads();
    }
    SEAM(0);

#pragma unroll 1
    for (int sb = 0; sb < 2; ++sb) {
        const int P = 1 + 7 * sb;
        const int T = sb ? 4096 : 2048, nB = sb ? 16 : 32;
        const float* xsb = A.x[sb]; float* outsb = A.out + (size_t)sb * SBTOK * DM;
        float* ssq1 = (float*)(ws + WS_SSQ1) + sb * SBTOK; float* ssq2 = (float*)(ws + WS_SSQ2) + sb * SBTOK;
        if (PHM(1) && IN(P)) { pg8::Gemm g{sb ? (const bf16*)outsb : (const bf16*)U, Wt_in, SBTOK, NP, DM}; pg8::StaticOrder S; S.init(SBTOK, NP, G, bx);
            pg8::EpiProj E{PROJ, biasp};
            pg8::gemm_phase<pg8::EpiProj, pg8::StaticOrder, true, true>(lds, g, S, E); }
        SEAM(P);
        bf16* QS = (bf16*)(ws + WS_U); bf16* HT = (bf16*)(ws + WS_U + 64 * MiB); float* DD = (float*)(ws + WS_U + 96 * MiB);
        const int nseg = T / GSEG, ngla = nB * 4 * nseg;
        if (IN(P + 1)) {
            if (PHM(2)) for (int item = bx; item < ngla; item += G) gla_pass1(lds, A, PROJ, (bf16*)outsb, QS, HT, DD, T, item / (4 * nseg), (item / nseg) & 3, item % nseg, tid);
            if (PHM(3)) na_phase(lds, A, PROJ, NAO, T, nB, ctl + 64 * (1 + sb), tid);
        }
        SEAM(P + 1);
        if (IN(P + 2)) {
            if (PHM(2)) for (int item = bx; item < ngla; item += G) gla_pass2(lds, A, PROJ, (const bf16*)outsb, QS, HT, DD, GLAO, T, item / (4 * nseg), (item / nseg) & 3, item % nseg, tid);
        }
        SEAM(P + 2);
        if (PHM(4) && IN(P + 3)) { pg8::Gemm g{NAO, Wt_na, SBTOK, DM, DM}; pg8::StaticOrder S; S.init(SBTOK, DM, G, bx); pg8::EpiBranchFused E{PROJ, U};
            pg8::gemm_phase<pg8::EpiBranchFused, pg8::StaticOrder, true, true>(lds, g, S, E); }
        SEAM(P + 3);
        if (PHM(5) && IN(P + 4)) { pg8::Gemm g{U, Wt_out, SBTOK, DM, DM}; pg8::StaticOrder S; S.init(SBTOK, DM, G, bx);
            pg8::EpiOut E{xsb, HB, ssq1};
            pg8::gemm_phase<pg8::EpiOut, pg8::StaticOrder, true, true>(lds, g, S, E); }
        SEAM(P + 4);
        if (PHM(6) && IN(P + 5)) { pg8::Gemm g{HB, Wt_up, SBTOK, DFF, DM}; pg8::StaticOrder S; S.init(SBTOK, DFF, G, bx);
            pg8::EpiUp E{ssq1, HDN};
            pg8::gemm_phase<pg8::EpiUp, pg8::StaticOrder, true, true>(lds, g, S, E); }
        SEAM(P + 5);
        if (PHM(7) && IN(P + 6)) { pg8::Gemm g{HDN, Wt_down, SBTOK, DM, DFF}; pg8::StaticOrder S; S.init(SBTOK, DM, G, bx);
            pg8::EpiDownNorm E{HB, outsb, ssq2, ctl + 1024 + sb * 256, A.norm_final_g};
            pg8::gemm_phase<pg8::EpiDownNorm, pg8::StaticOrder, true, true, true>(lds, g, S, E); }
        if (sb == 0) SEAM(P + 6);
    }
#undef IN
#undef SEAM
}

extern "C" void kernel_launch(void* const* d_in, const int* in_sizes, int n_in, void* d_out, int out_size, void* d_ws, size_t ws_size, hipStream_t stream) {
    static int grid = 0;
    if (grid == 0) {
        if (n_in != 18 || ws_size < WS_END) { fprintf(stderr, "kernel_launch: unexpected n_in %d / ws_size %zu\n", n_in, ws_size); grid = -1; return; }
        int dev = 0, cus = 0, per_cu = 0;
        hipGetDevice(&dev); hipDeviceGetAttribute(&cus, hipDeviceAttributeMultiprocessorCount, dev);
        if (hipFuncSetAttribute((const void*)fwd_kernel, hipFuncAttributeMaxDynamicSharedMemorySize, LDS_BYTES) != hipSuccess) { fprintf(stderr, "kernel_launch: hipFuncSetAttribute failed\n"); grid = -1; return; }
        if (hipOccupancyMaxActiveBlocksPerMultiprocessor(&per_cu, (const void*)fwd_kernel, NTHR, LDS_BYTES) != hipSuccess || per_cu < 1) { fprintf(stderr, "kernel_launch: occupancy query says %d\n", per_cu); per_cu = 1; }
        (void)hipGetLastError();
        grid = cus * per_cu;
    }
    if (grid < 0) return;
    hipMemsetAsync((char*)d_ws + WS_CTL, 0, CTL_BYTES, stream);
    Args a{};
    a.x[0] = (const float*)d_in[0]; a.x[1] = (const float*)d_in[1]; a.norm_mix_g = (const float*)d_in[2]; a.w_in = (const float*)d_in[3]; a.b_in = (const float*)d_in[4];
    a.na_rpb = (const float*)d_in[5]; a.gk_w[0] = (const float*)d_in[6]; a.gk_b[0] = (const float*)d_in[7]; a.gk_w[1] = (const float*)d_in[8]; a.gk_b[1] = (const float*)d_in[9];
    a.gla_norm_g = (const float*)d_in[10]; a.w_br_na = (const float*)d_in[11]; a.w_br_gla = (const float*)d_in[12]; a.w_out = (const float*)d_in[13];
    a.norm_mlp_g = (const float*)d_in[14]; a.w_up = (const float*)d_in[15]; a.w_down = (const float*)d_in[16]; a.norm_final_g = (const float*)d_in[17];
    a.out = (float*)d_out; a.ws = (unsigned char*)d_ws;
#if MK_SINGLE
    a.ph_lo = 0; a.ph_hi = N_PHASES; a.coop = 1;
    void* args[] = {&a};
    hipError_t e = hipLaunchCooperativeKernel((const void*)fwd_kernel, dim3(grid), dim3(NTHR), args, LDS_BYTES, stream);
    if (e != hipSuccess) fprintf(stderr, "cooperative launch failed: %s (grid %d)\n", hipGetErrorString(e), grid);
#else
    for (int p = 0; p < N_PHASES; ++p) { a.ph_lo = p; a.ph_hi = p + 1; a.coop = 0;
        hipLaunchKernelGGL(fwd_kernel, dim3(grid), dim3(NTHR), LDS_BYTES, stream, a); }
#endif
}
```

```cpp
#include <hip/hip_runtime.h>
#include <hip/hip_cooperative_groups.h>
#include <cstdio>
#include <cstdint>
namespace cg = cooperative_groups;

#ifndef MK_SINGLE
#define MK_SINGLE 1
#endif

constexpr int DM = 1024, DFF = 4096, NP = 5376  , SBTOK = 65536;
constexpr int C_NAQ = 0, C_NAK = 512, C_NAV = 1024, C_GQ = 1536, C_GK = 1792, C_GV = 2048, C_GG = 2560, C_SNA = 3072, C_SGLA = 4096, C_LR = 5120;
constexpr float RMS_EPS = 1e-6f;
namespace pg8 {
#define PG8_LAS __attribute__((address_space(3)))
typedef unsigned short bf16_t;
typedef short bf16x8 __attribute__((ext_vector_type(8)));
typedef float f32x4 __attribute__((ext_vector_type(4)));
typedef unsigned u32x4 __attribute__((ext_vector_type(4)));
constexpr int BM = 256, BK = 64, HALF = 128, HTB = HALF * BK * 2  , STAGE_BYTES = 8 * HTB, NXCD = 8, WGM = 8;

__host__ __device__ __forceinline__ int lds_byte(int r, int c) { const int st = (r >> 4) * 2 + (c >> 5), rr = r & 15, cc = c & 31, ob = rr * 64 + cc * 2; return st * 1024 + (ob ^ (((ob >> 9) & 1) << 5)); }
__host__ __device__ __forceinline__ void stage_rc(int b, int& R, int& C) { const int st = b / 1024, sb = b % 1024, swz = sb ^ (((sb >> 9) & 1) << 5); R = (st >> 1) * 16 + swz / 64; C = (st & 1) * 32 + (swz % 64) / 2; }
__host__ __device__ __forceinline__ int perm32(int rho) { const int n = rho >> 4, i = rho & 15; return 8 * (i >> 2) + 4 * n + (i & 3); }

struct Unit { int pm, pn; };
struct Gemm { const bf16_t* A; const bf16_t* Bt; int M, N, K; };

struct StaticOrder {
    int nM, nN, nwg, G, c;
    __host__ __device__ void init(int M, int N, int G_, int c_) { nM = M / BM; nN = N / BM; nwg = nM * nN; G = G_; c = c_; }
    __host__ __device__ bool next(int i, Unit& u) const {
        const long L = (long)i * G + c; if (L >= nwg) return false;
        int wgid = (int)L; { const int q = nwg / NXCD, r = nwg % NXCD, xcd = wgid % NXCD, off = wgid / NXCD; wgid = (xcd < r ? xcd * (q + 1) : r * (q + 1) + (xcd - r) * q) + off; }
        const int nig = WGM * nN, gid = wgid / nig, fm = gid * WGM, gsz = (nM - fm) < WGM ? (nM - fm) : WGM;
        u.pm = fm + ((wgid % nig) % gsz); u.pn = (wgid % nig) / gsz; return true;
    }
    __device__ __forceinline__ void a_ready(const Unit&) const {}
    __device__ __forceinline__ void done(const Unit&) const {}
};

__device__ __forceinline__ unsigned cvt_pk_bf16(float lo, float hi) { unsigned r; asm volatile("v_cvt_pk_bf16_f32 %0, %1, %2" : "=v"(r) : "v"(lo), "v"(hi)); return r; }
typedef unsigned u32x2 __attribute__((ext_vector_type(2)));
__device__ __forceinline__ float bf2f(unsigned short b) { return __uint_as_float((unsigned)b << 16); }
__device__ __forceinline__ float sigmoidf_(float x) { return __builtin_amdgcn_rcpf(1.0f + __builtin_amdgcn_exp2f(-1.4426950408889634f * x)); }

struct EpiProj {
    static constexpr bool PERM = true, AFTER_DRAIN = false, MID = false;
    bf16_t* O; const float* bias;
    __device__ __forceinline__ void operator()(const f32x4 (&acc)[2][2][4][2], const Unit& u, int wr, int wc, int fr, int fq) const {
        const int row0 = u.pm * BM + wr * 64 + fr, pn = u.pn;
        const int mode = (pn < 2 || pn == 6) ? 1 : ((pn == 10 || pn == 11) ? 2 : ((pn >= 12 && pn < 20) ? 3 : 0));
        const int col0 = pn * BM + wc * 32 + 8 * fq;
        f32x4 bv[2][2];
#pragma unroll
        for (int bj = 0; bj < 2; ++bj)
#pragma unroll
            for (int n = 0; n < 2; ++n) bv[bj][n] = *(const f32x4*)(bias + col0 + bj * HALF + 4 * n);
#pragma unroll
        for (int ai = 0; ai < 2; ++ai)
#pragma unroll
            for (int m = 0; m < 4; ++m) { bf16_t* rowp = O + (size_t)(row0 + ai * HALF + m * 16) * NP + col0;
#pragma unroll
                for (int bj = 0; bj < 2; ++bj) { f32x4 v0 = acc[ai][bj][m][0] + bv[bj][0], v1 = acc[ai][bj][m][1] + bv[bj][1];
                    if (mode == 1) { v0 = v0 * 0.125f; v1 = v1 * 0.125f; }
                    else if (mode == 2) {
#pragma unroll
                        for (int e = 0; e < 4; ++e) { v0[e] = v0[e] * sigmoidf_(v0[e]); v1[e] = v1[e] * sigmoidf_(v1[e]); } }
                    else if (mode == 3) {
#pragma unroll
                        for (int e = 0; e < 4; ++e) { v0[e] = sigmoidf_(v0[e]); v1[e] = sigmoidf_(v1[e]); } }
                    u32x4 w; w.x = cvt_pk_bf16(v0[0], v0[1]); w.y = cvt_pk_bf16(v0[2], v0[3]); w.z = cvt_pk_bf16(v1[0], v1[1]); w.w = cvt_pk_bf16(v1[2], v1[3]);
                    *(u32x4*)(rowp + bj * HALF) = w; } }
    }
};

template <bool ADD> struct EpiBranch {
    static constexpr bool PERM = true, AFTER_DRAIN = false, MID = false;
    const bf16_t* proj; int gcol; bf16_t* O;
    __device__ __forceinline__ void operator()(const f32x4 (&acc)[2][2][4][2], const Unit& u, int wr, int wc, int fr, int fq) const {
        const int row0 = u.pm * BM + wr * 64 + fr, col0 = u.pn * BM + wc * 32 + 8 * fq;
#pragma unroll
        for (int ai = 0; ai < 2; ++ai)
#pragma unroll
            for (int m = 0; m < 4; ++m) { const size_t r = (size_t)(row0 + ai * HALF + m * 16);
#pragma unroll
                for (int bj = 0; bj < 2; ++bj) {
                    const u32x4 gw = *(const u32x4*)(proj + r * NP + gcol + col0 + bj * HALF);
                    u32x4 pw = (u32x4){0u, 0u, 0u, 0u}; if (ADD) pw = *(const u32x4*)(O + r * DM + col0 + bj * HALF);
                    float o[8];
#pragma unroll
                    for (int e = 0; e < 8; ++e) { const unsigned g2 = gw[e >> 1], p2 = pw[e >> 1];
                        const float gt = (e & 1) ? __uint_as_float(g2 & 0xffff0000u) : __uint_as_float(g2 << 16);
                        const float pv = (e & 1) ? __uint_as_float(p2 & 0xffff0000u) : __uint_as_float(p2 << 16);
                        o[e] = pv + gt * acc[ai][bj][m][e >> 2][e & 3]; }
                    u32x4 w; w.x = cvt_pk_bf16(o[0], o[1]); w.y = cvt_pk_bf16(o[2], o[3]); w.z = cvt_pk_bf16(o[4], o[5]); w.w = cvt_pk_bf16(o[6], o[7]);
                    *(u32x4*)(O + r * DM + col0 + bj * HALF) = w; }
                asm volatile("" ::: "memory"); }
    }
};

struct EpiBranchFused {
    static constexpr bool PERM = true, AFTER_DRAIN = false, MID = true;
    const bf16_t* proj; bf16_t* O;
    __device__ __forceinline__ void mid(f32x4 (&acc)[2][2][4][2], const Unit& u, int wr, int wc, int fr_in, int fq_in) const {
        int fr = fr_in, fq = fq_in; asm volatile("" : "+v"(fr), "+v"(fq));
        const int row0 = u.pm * BM + wr * 64 + fr, col0 = u.pn * BM + wc * 32 + 8 * fq;
#pragma unroll
        for (int ai = 0; ai < 2; ++ai)
#pragma unroll
            for (int m = 0; m < 4; ++m) { const size_t r = (size_t)(row0 + ai * HALF + m * 16);
#pragma unroll
                for (int bj = 0; bj < 2; ++bj) {
                    const u32x4 ga = *(const u32x4*)(proj + r * NP + C_SNA + col0 + bj * HALF), gb = *(const u32x4*)(proj + r * NP + C_SGLA + col0 + bj * HALF);
#pragma unroll
                    for (int e = 0; e < 8; ++e) { const unsigned a2 = ga[e >> 1], b2 = gb[e >> 1];
                        const float sa = (e & 1) ? __uint_as_float(a2 & 0xffff0000u) : __uint_as_float(a2 << 16), sb = (e & 1) ? __uint_as_float(b2 & 0xffff0000u) : __uint_as_float(b2 << 16);
                        acc[ai][bj][m][e >> 2][e & 3] *= sa * __builtin_amdgcn_rcpf(sb); } }
                if (m == 3) asm volatile("" ::: "memory"); }
    }
    __device__ __forceinline__ void operator()(const f32x4 (&acc)[2][2][4][2], const Unit& u, int wr, int wc, int fr, int fq) const {
        const int row0 = u.pm * BM + wr * 64 + fr, col0 = u.pn * BM + wc * 32 + 8 * fq;
#pragma unroll
        for (int ai = 0; ai < 2; ++ai)
#pragma unroll
            for (int m = 0; m < 4; ++m) { const size_t r = (size_t)(row0 + ai * HALF + m * 16);
#pragma unroll
                for (int bj = 0; bj < 2; ++bj) {
                    const u32x4 gb = *(const u32x4*)(proj + r * NP + C_SGLA + col0 + bj * HALF);
                    float o[8];
#pragma unroll
                    for (int e = 0; e < 8; ++e) { const unsigned b2 = gb[e >> 1]; const float sb = (e & 1) ? __uint_as_float(b2 & 0xffff0000u) : __uint_as_float(b2 << 16);
                        o[e] = sb * acc[ai][bj][m][e >> 2][e & 3]; }
                    u32x4 w; w.x = cvt_pk_bf16(o[0], o[1]); w.y = cvt_pk_bf16(o[2], o[3]); w.z = cvt_pk_bf16(o[4], o[5]); w.w = cvt_pk_bf16(o[6], o[7]);
                    *(u32x4*)(O + r * DM + col0 + bj * HALF) = w; }
                if (m == 3) asm volatile("" ::: "memory"); }
    }
};

struct EpiOut {
    static constexpr bool PERM = false, AFTER_DRAIN = false, MID = false;
    const float* base; bf16_t* hb; float* ssq;
    __device__ __forceinline__ void operator()(const f32x4 (&acc)[2][2][4][2], const Unit& u, int wr, int wc, int fr, int fq) const {
        const int col0 = u.pn * BM + wc * 32 + 4 * fq;
#pragma unroll
        for (int ai = 0; ai < 2; ++ai) {
            f32x4 xv[4][2][2];
#pragma unroll
            for (int m = 0; m < 4; ++m) { const size_t r = (size_t)(u.pm * BM + ai * HALF + wr * 64 + m * 16 + fr);
#pragma unroll
                for (int bj = 0; bj < 2; ++bj)
#pragma unroll
                    for (int n = 0; n < 2; ++n) xv[m][bj][n] = *(const f32x4*)(base + r * DM + col0 + bj * HALF + n * 16); }
#pragma unroll
            for (int m = 0; m < 4; ++m) { const size_t r = (size_t)(u.pm * BM + ai * HALF + wr * 64 + m * 16 + fr); float s = 0.f;
#pragma unroll
                for (int bj = 0; bj < 2; ++bj)
#pragma unroll
                    for (int n = 0; n < 2; ++n) { const size_t off = r * DM + col0 + bj * HALF + n * 16;
                        const f32x4 h = xv[m][bj][n] + acc[ai][bj][m][n];
                        s += (h[0] * h[0] + h[1] * h[1]) + (h[2] * h[2] + h[3] * h[3]);
                        u32x2 w; w.x = cvt_pk_bf16(h[0], h[1]); w.y = cvt_pk_bf16(h[2], h[3]); *(u32x2*)(hb + off) = w; }
                s += __shfl_xor(s, 16); s += __shfl_xor(s, 32);
                if (fq == 0) atomicAdd(ssq + r, s); }
            asm volatile("" ::: "memory"); }
    }
};
struct EpiDownNorm {
    static constexpr bool PERM = false, AFTER_DRAIN = false, MID = false;
    const bf16_t* hb; float* out; float* ssq; unsigned* cnt; const float* gain;
    __device__ __forceinline__ void operator()(const f32x4 (&acc_)[2][2][4][2], const Unit& u, int wr, int wc, int fr, int fq) const {
        f32x4 (&acc)[2][2][4][2] = const_cast<f32x4 (&)[2][2][4][2]>(acc_);
        const int col0 = u.pn * BM + wc * 32 + 4 * fq;
#pragma unroll
        for (int ai = 0; ai < 2; ++ai) {
            u32x2 hv[4][2][2];
#pragma unroll
            for (int m = 0; m < 4; ++m) { const size_t r = (size_t)(u.pm * BM + ai * HALF + wr * 64 + m * 16 + fr);
#pragma unroll
                for (int bj = 0; bj < 2; ++bj)
#pragma unroll
                    for (int n = 0; n < 2; ++n) hv[m][bj][n] = *(const u32x2*)(hb + r * DM + col0 + bj * HALF + n * 16); }
#pragma unroll
            for (int m = 0; m < 4; ++m) { const size_t r = (size_t)(u.pm * BM + ai * HALF + wr * 64 + m * 16 + fr); float s = 0.f;
#pragma unroll
                for (int bj = 0; bj < 2; ++bj)
#pragma unroll
                    for (int n = 0; n < 2; ++n) { const u32x2 hw = hv[m][bj][n];
                        f32x4 h = acc[ai][bj][m][n];
                        h[0] += __uint_as_float(hw.x << 16); h[1] += __uint_as_float(hw.x & 0xffff0000u); h[2] += __uint_as_float(hw.y << 16); h[3] += __uint_as_float(hw.y & 0xffff0000u);
                        acc[ai][bj][m][n] = h; s += (h[0] * h[0] + h[1] * h[1]) + (h[2] * h[2] + h[3] * h[3]); }
                s += __shfl_xor(s, 16); s += __shfl_xor(s, 32);
                if (fq == 0) atomicAdd(ssq + r, s); }
            asm volatile("" ::: "memory"); }
        asm volatile("s_waitcnt vmcnt(0)" ::: "memory");
        if ((threadIdx.x & 63) == 0) __hip_atomic_fetch_add(cnt + u.pm, 1u, __ATOMIC_RELAXED, __HIP_MEMORY_SCOPE_AGENT);
        {   unsigned spins = 0;
            while ((unsigned)__builtin_amdgcn_readfirstlane((int)__hip_atomic_load(cnt + u.pm, __ATOMIC_RELAXED, __HIP_MEMORY_SCOPE_AGENT)) < 32u) { __builtin_amdgcn_s_sleep(2); if (++spins > (1u << 22)) break; } }
        asm volatile("" ::: "memory");
#pragma unroll
        for (int ai = 0; ai < 2; ++ai)
#pragma unroll
            for (int m = 0; m < 4; ++m) { const size_t r = (size_t)(u.pm * BM + ai * HALF + wr * 64 + m * 16 + fr);
                const float rstd = rsqrtf(__hip_atomic_load(ssq + r, __ATOMIC_RELAXED, __HIP_MEMORY_SCOPE_AGENT) * (1.0f / DM) + RMS_EPS);
#pragma unroll
                for (int bj = 0; bj < 2; ++bj)
#pragma unroll
                    for (int n = 0; n < 2; ++n) { const size_t off = r * DM + col0 + bj * HALF + n * 16; const f32x4 gg = *(const f32x4*)(gain + col0 + bj * HALF + n * 16);
                        *(f32x4*)(out + off) = acc[ai][bj][m][n] * rstd * gg; }
                asm volatile("" ::: "memory"); }
    }
};

struct EpiUp {
    static constexpr bool PERM = true, AFTER_DRAIN = false, MID = false;
    const float* ssq; bf16_t* O;
    __device__ __forceinline__ void operator()(const f32x4 (&acc)[2][2][4][2], const Unit& u, int wr, int wc, int fr, int fq) const {
        const int row0 = u.pm * BM + wr * 64 + fr, col0 = u.pn * BM + wc * 32 + 8 * fq;
#pragma unroll
        for (int ai = 0; ai < 2; ++ai)
#pragma unroll
            for (int m = 0; m < 4; ++m) { const size_t r = (size_t)(row0 + ai * HALF + m * 16);
                const float rstd = rsqrtf(ssq[r] * (1.0f / DM) + RMS_EPS);
#pragma unroll
                for (int bj = 0; bj < 2; ++bj) { f32x4 v0 = acc[ai][bj][m][0] * rstd, v1 = acc[ai][bj][m][1] * rstd;
#pragma unroll
                    for (int e = 0; e < 4; ++e) { const float a = fmaxf(v0[e], 0.f), b = fmaxf(v1[e], 0.f); v0[e] = a * a; v1[e] = b * b; }
                    u32x4 w; w.x = cvt_pk_bf16(v0[0], v0[1]); w.y = cvt_pk_bf16(v0[2], v0[3]); w.z = cvt_pk_bf16(v1[0], v1[1]); w.w = cvt_pk_bf16(v1[2], v1[3]);
                    const int col = col0 + bj * HALF;
                    *(u32x4*)(O + ((((r >> 8) * (DFF / 64) + (col >> 6)) * 256 + (r & 255)) * 64 + (col & 63))) = w; } }
    }
};

template <class Epi, class Sched, bool ALIGN_EPI = false, bool SP2 = false, bool TILED = false>
__device__ __forceinline__ void gemm_phase(PG8_LAS unsigned char* lds, const Gemm g, const Sched& S, const Epi& E) {
    int tid_ = threadIdx.x; asm volatile("" : "+v"(tid_));
    const int tid = tid_, wid = __builtin_amdgcn_readfirstlane(tid >> 6), lane = tid & 63, wr = wid >> 2, wc = wid & 3, fr = lane & 15, fq = lane >> 4;
    const int K = g.K, nt = K / BK;
    unsigned voffA[2], voffB[2];
#pragma unroll
    for (int i = 0; i < 2; ++i) { int R, C; stage_rc(tid * 16 + i * 8192, R, C); const int Rb = Epi::PERM ? ((R & ~31) + perm32(R & 31)) : R;
        const int rs = TILED ? BK : K; voffA[i] = (unsigned)(R * rs + C) * 2u; voffB[i] = (unsigned)(Rb * rs + C) * 2u; }
    const size_t kstep = TILED ? (size_t)(BM * BK * 2) : (size_t)(BK * 2);
    const size_t hstep = TILED ? (size_t)(HALF * BK * 2) : (size_t)HALF * K * 2;
    const size_t tstep = TILED ? (size_t)(K / BK) * (BM * BK * 2) : 2 * hstep;
    const unsigned ldsw = (unsigned)wid * 1024u;
    const int aoff = lds_byte(wr * 64 + fr, fq * 8), boff = lds_byte(wc * 32 + fr, fq * 8);
#define PG8_SA(b, h) (((b) * 2 + (h)) * HTB)
#define PG8_SB(b, h) ((4 + (b) * 2 + (h)) * HTB)
#define PG8_STAGE(bufoff, gbase, voff) do { _Pragma("unroll") for (int _i = 0; _i < 2; ++_i) \
        __builtin_amdgcn_global_load_lds((const unsigned*)((const char*)(gbase) + (voff)[_i]), (PG8_LAS unsigned*)(lds + (bufoff) + ldsw + _i * 8192), 16, 0, 0); } while (0)
#define PG8_LDA(dst, b, h) do { _Pragma("unroll") for (int m = 0; m < 4; ++m) _Pragma("unroll") for (int k = 0; k < 2; ++k) dst[m][k] = *(const PG8_LAS bf16x8*)(lds + PG8_SA(b, h) + aoff + m * 2048 + k * 1024); } while (0)
#define PG8_LDB(dst, b, h) do { _Pragma("unroll") for (int n = 0; n < 2; ++n) _Pragma("unroll") for (int k = 0; k < 2; ++k) dst[n][k] = *(const PG8_LAS bf16x8*)(lds + PG8_SB(b, h) + boff + n * 2048 + k * 1024); } while (0)
#define PG8_MMA(ai, bj, At, Bt) do { __builtin_amdgcn_s_setprio(1); _Pragma("unroll") for (int m = 0; m < 4; ++m) _Pragma("unroll") for (int n = 0; n < 2; ++n) _Pragma("unroll") for (int k = 0; k < 2; ++k) \
        acc[ai][bj][m][n] = __builtin_amdgcn_mfma_f32_16x16x32_bf16(Bt[n][k], At[m][k], acc[ai][bj][m][n], 0, 0, 0); __builtin_amdgcn_s_setprio(0); } while (0)
#define PG8_WAIT_V(n) asm volatile("s_waitcnt vmcnt(" #n ")" ::: "memory")
#define PG8_WAIT_L(n) asm volatile("s_waitcnt lgkmcnt(" #n ")" ::: "memory")
#define PG8_BAR __builtin_amdgcn_s_barrier()
#define PG8_SCHED __builtin_amdgcn_sched_barrier(0)
    Unit cur, nxt; int ui = 0;
    if (!S.next(0, cur)) return;
    f32x4 acc[2][2][4][2];
#pragma unroll
    for (int a = 0; a < 2; ++a)
#pragma unroll
        for (int b = 0; b < 2; ++b)
#pragma unroll
            for (int m = 0; m < 4; ++m)
#pragma unroll
                for (int n = 0; n < 2; ++n) acc[a][b][m][n] = (f32x4){0.f, 0.f, 0.f, 0.f};
    bf16x8 At[4][2], B0[2][2], B1[2][2];
    const char* cA = (const char*)g.A + (size_t)cur.pm * tstep; const char* cB = (const char*)g.Bt + (size_t)cur.pn * tstep;
    S.a_ready(cur);
    if constexpr (SP2) {
        PG8_STAGE(PG8_SB(0, 0), cB, voffB); PG8_STAGE(PG8_SB(0, 1), cB + hstep, voffB); PG8_STAGE(PG8_SA(0, 0), cA, voffA); PG8_STAGE(PG8_SA(0, 1), cA + hstep, voffA);
        if (wr == 1) PG8_BAR;
        PG8_WAIT_V(2); PG8_BAR;
        PG8_STAGE(PG8_SB(1, 0), cB + kstep, voffB); PG8_STAGE(PG8_SA(1, 0), cA + kstep, voffA); PG8_STAGE(PG8_SB(1, 1), cB + hstep + kstep, voffB);
        PG8_WAIT_V(6); PG8_BAR;
    } else {
        PG8_STAGE(PG8_SB(0, 0), cB, voffB); PG8_STAGE(PG8_SA(0, 0), cA, voffA); PG8_STAGE(PG8_SB(0, 1), cB + hstep, voffB); PG8_STAGE(PG8_SA(0, 1), cA + hstep, voffA);
        if (wr == 1) PG8_BAR;
        PG8_WAIT_V(4); PG8_BAR;
        PG8_STAGE(PG8_SB(1, 0), cB + kstep, voffB); PG8_STAGE(PG8_SA(1, 0), cA + kstep, voffA); PG8_STAGE(PG8_SB(1, 1), cB + hstep + kstep, voffB);
        PG8_WAIT_V(6); PG8_BAR;
    }
    for (;;) {
        const bool has_next = S.next(ui + 1, nxt);
        const char* nA = has_next ? (const char*)g.A + (size_t)nxt.pm * tstep : cA; const char* nB = has_next ? (const char*)g.Bt + (size_t)nxt.pn * tstep : cB;
        for (int t = 0; t < nt; t += 2) {
            const bool last = (t == nt - 2);
            const char* a1 = cA + (size_t)(t + 1) * kstep;
            const char* a2 = last ? nA : cA + (size_t)(t + 2) * kstep; const char* b2 = last ? nB : cB + (size_t)(t + 2) * kstep;
            const char* a3 = a2 + kstep; const char* b3 = b2 + kstep;
            if (last && has_next) S.a_ready(nxt);
            if constexpr (Epi::MID) { if (t == nt / 2) E.mid(acc, cur, wr, wc, fr, fq); }
            if constexpr (SP2) {
            PG8_LDB(B0, 0, 0); PG8_LDB(B1, 0, 1); PG8_SCHED; PG8_LDA(At, 0, 0); PG8_STAGE(PG8_SA(1, 1), a1 + hstep, voffA);
            PG8_WAIT_V(8); PG8_WAIT_L(0); PG8_BAR; PG8_MMA(0, 0, At, B0); PG8_MMA(0, 1, At, B1); PG8_BAR; PG8_SCHED;
            PG8_LDA(At, 0, 1); PG8_STAGE(PG8_SB(0, 0), b2, voffB); PG8_STAGE(PG8_SB(0, 1), b2 + hstep, voffB); PG8_STAGE(PG8_SA(0, 0), a2, voffA);
            PG8_WAIT_V(8); PG8_WAIT_L(0); PG8_BAR; PG8_MMA(1, 0, At, B0); PG8_MMA(1, 1, At, B1); PG8_BAR; PG8_SCHED;
            PG8_LDB(B0, 1, 0); PG8_LDB(B1, 1, 1); PG8_SCHED; PG8_LDA(At, 1, 0); PG8_STAGE(PG8_SA(0, 1), a2 + hstep, voffA);
            PG8_WAIT_V(8); PG8_WAIT_L(0); PG8_BAR; PG8_MMA(0, 0, At, B0); PG8_MMA(0, 1, At, B1); PG8_BAR; PG8_SCHED;
            PG8_LDA(At, 1, 1); PG8_STAGE(PG8_SB(1, 0), b3, voffB); PG8_STAGE(PG8_SB(1, 1), b3 + hstep, voffB); PG8_STAGE(PG8_SA(1, 0), a3, voffA);
            PG8_WAIT_V(8); PG8_WAIT_L(0); PG8_BAR; PG8_MMA(1, 0, At, B0); PG8_MMA(1, 1, At, B1); PG8_BAR; PG8_SCHED;
            } else {
            PG8_LDB(B0, 0, 0); PG8_SCHED; PG8_LDA(At, 0, 0); PG8_STAGE(PG8_SA(1, 1), a1 + hstep, voffA);
            PG8_WAIT_L(8); PG8_BAR; PG8_WAIT_L(0); PG8_MMA(0, 0, At, B0); PG8_BAR; PG8_SCHED;
            PG8_LDB(B1, 0, 1); PG8_STAGE(PG8_SB(0, 0), b2, voffB);
            PG8_BAR; PG8_WAIT_L(0); PG8_MMA(0, 1, At, B1); PG8_BAR;
            PG8_LDA(At, 0, 1); PG8_STAGE(PG8_SA(0, 0), a2, voffA);
            PG8_BAR; PG8_WAIT_L(0); PG8_MMA(1, 0, At, B0); PG8_BAR; PG8_SCHED;
            PG8_STAGE(PG8_SB(0, 1), b2 + hstep, voffB);
            PG8_WAIT_V(6); PG8_BAR; PG8_MMA(1, 1, At, B1); PG8_BAR;
            PG8_LDB(B0, 1, 0); PG8_SCHED; PG8_LDA(At, 1, 0); PG8_STAGE(PG8_SA(0, 1), a2 + hstep, voffA);
            PG8_WAIT_L(8); PG8_BAR; PG8_WAIT_L(0); PG8_MMA(0, 0, At, B0); PG8_BAR; PG8_SCHED;
            PG8_LDB(B1, 1, 1); PG8_STAGE(PG8_SB(1, 0), b3, voffB);
            PG8_BAR; PG8_WAIT_L(0); PG8_MMA(0, 1, At, B1); PG8_BAR;
            PG8_LDA(At, 1, 1); PG8_STAGE(PG8_SA(1, 0), a3, voffA);
            PG8_BAR; PG8_WAIT_L(0); PG8_MMA(1, 0, At, B0); PG8_BAR; PG8_SCHED;
            PG8_STAGE(PG8_SB(1, 1), b3 + hstep, voffB);
            PG8_WAIT_V(6); PG8_BAR; PG8_MMA(1, 1, At, B1); PG8_BAR;
            }
        }
        if constexpr (ALIGN_EPI) { if (wr == 0) PG8_BAR; }
        if constexpr (!Epi::AFTER_DRAIN) { E(acc, cur, wr, wc, fr, fq); S.done(cur); }
        if (!has_next) break;
#pragma unroll
        for (int a = 0; a < 2; ++a)
#pragma unroll
            for (int b = 0; b < 2; ++b)
#pragma unroll
                for (int m = 0; m < 4; ++m)
#pragma unroll
                    for (int n = 0; n < 2; ++n) acc[a][b][m][n] = (f32x4){0.f, 0.f, 0.f, 0.f};
        cur = nxt; cA = nA; cB = nB; ++ui;
        if constexpr (ALIGN_EPI) { if (wr == 1) PG8_BAR; }
    }
    PG8_WAIT_V(0);
    if constexpr (!ALIGN_EPI) { if (wr == 0) PG8_BAR; }
    PG8_BAR;
    if constexpr (Epi::AFTER_DRAIN) { E.fused(acc, cur, wr, wc, fr, fq, lds, wid, lane); S.done(cur); }
#undef PG8_SA
#undef PG8_SB
#undef PG8_STAGE
#undef PG8_LDA
#undef PG8_LDB
#undef PG8_MMA
#undef PG8_WAIT_V
#undef PG8_WAIT_L
#undef PG8_BAR
#undef PG8_SCHED
}
}

#define LAS __attribute__((address_space(3)))
#define DI __device__ __forceinline__
typedef unsigned short bf16;
typedef short bf16x8 __attribute__((ext_vector_type(8)));
typedef short s16x4 __attribute__((ext_vector_type(4)));
typedef float f32x4 __attribute__((ext_vector_type(4)));
typedef float f32x2 __attribute__((ext_vector_type(2)));
typedef unsigned u32x4 __attribute__((ext_vector_type(4)));
typedef unsigned u32x2 __attribute__((ext_vector_type(2)));
typedef __bf16 bf16v2 __attribute__((ext_vector_type(2)));
constexpr int NWAVES = 8, NTHR = 512;
constexpr int LDS_BYTES = 155648;

constexpr size_t MiB = 1u << 20;
constexpr size_t WS_CTL = 0, CTL_BYTES = 2 * MiB;
constexpr size_t WS_SSQ1 = 512 * 1024, WS_SSQ2 = 1024 * 1024;
constexpr size_t WS_WIN = 2 * MiB, WS_WNA = 13 * MiB, WS_WGLA = 14 * MiB, WS_WOUT = 15 * MiB, WS_WUP = 17 * MiB, WS_WDOWN = 25 * MiB, WS_BIAS = 33 * MiB;
constexpr size_t WS_U = 34 * MiB;
constexpr size_t WS_NAO = 162 * MiB, WS_GLAO = 226 * MiB;
constexpr size_t WS_PROJ = 290 * MiB;
constexpr size_t WS_END = 962 * MiB;

DI float bf2f(unsigned short b) { return __uint_as_float((unsigned)b << 16); }
DI unsigned pk2(float lo, float hi) { f32x2 v = {lo, hi}; bf16v2 b = __builtin_convertvector(v, bf16v2); return __builtin_bit_cast(unsigned, b); }
DI unsigned short f2bf(float x) { return (unsigned short)(pk2(x, 0.f) & 0xffffu); }
DI float wave_sum(float v) {
#pragma unroll
    for (int o = 1; o < 64; o <<= 1) v += __shfl_xor(v, o);
    return v;
}
#define LDS_WAIT() asm volatile("s_waitcnt lgkmcnt(0)" ::: "memory")
#define BAR_LDS() do { asm volatile("s_waitcnt lgkmcnt(0)" ::: "memory"); __builtin_amdgcn_s_barrier(); asm volatile("" ::: "memory"); } while (0)
#define MFMA32(a, b, c) __builtin_amdgcn_mfma_f32_16x16x32_bf16((a), (b), (c), 0, 0, 0)
#define MFMA16(a, b, c) __builtin_amdgcn_mfma_f32_16x16x16bf16_1k((a), (b), (c), 0, 0, 0)

struct Args {
    const float* x[2]; const float* norm_mix_g; const float* w_in; const float* b_in; const float* na_rpb;
    const float* gk_w[2]; const float* gk_b[2]; const float* gla_norm_g; const float* w_br_na; const float* w_br_gla; const float* w_out;
    const float* norm_mlp_g; const float* w_up; const float* w_down; const float* norm_final_g;
    float* out; unsigned char* ws; int ph_lo, ph_hi, coop, pad;
};

template <int MODE>
DI void transpose_item(const float* W, int K, int N, bf16* WT, LAS float* scr, int item, int lane, const float* g, int ldk = 0, int koff = 0) {
    if (ldk == 0) ldk = K;
    const int nblk = N / 32, kb = item / nblk, nb = item % nblk, k0 = 64 * kb, n0 = 32 * nb;
#pragma unroll 8
    for (int i = 0; i < 32; ++i) { const int kk = 2 * i + (lane >> 5); float v = W[(size_t)(k0 + kk) * N + n0 + (lane & 31)]; if (MODE == 2) v *= g[k0 + kk]; scr[kk * 33 + (lane & 31)] = v; }
    LDS_WAIT();
    int d0 = n0; if (MODE == 1) d0 = (n0 < 3072) ? n0 : ((n0 < 3104) ? (C_LR + (n0 - 3072)) : (n0 - 32));
    const int c = lane & 7;
#pragma unroll
    for (int j = 0; j < 4; ++j) { const int n = (lane >> 3) + 8 * j; const LAS float* s = scr + (8 * c) * 33 + n;
        u32x4 o; o.x = pk2(s[0 * 33], s[1 * 33]); o.y = pk2(s[2 * 33], s[3 * 33]); o.z = pk2(s[4 * 33], s[5 * 33]); o.w = pk2(s[6 * 33], s[7 * 33]);
        if (MODE == 3) *(u32x4*)(WT + ((((size_t)((d0 + n) >> 8) * (K / 64) + (k0 >> 6)) * 256 + ((d0 + n) & 255)) * 64 + 8 * c)) = o;
        else *(u32x4*)(WT + (size_t)(d0 + n) * ldk + koff + k0 + 8 * c) = o; }
    LDS_WAIT();
}
DI void rms_row2_to_bf16(const float* xrow0, const float* xrow1, const float* g, bf16* orow0, bf16* orow1, int lane) {
    const f32x4* xr0 = (const f32x4*)xrow0 + lane; const f32x4* xr1 = (const f32x4*)xrow1 + lane; const f32x4* gr = (const f32x4*)g + lane;
    f32x4 v0[4], v1[4]; float s0 = 0.f, s1 = 0.f;
#pragma unroll
    for (int j = 0; j < 4; ++j) { v0[j] = __builtin_nontemporal_load(xr0 + 64 * j); v1[j] = __builtin_nontemporal_load(xr1 + 64 * j); }
#pragma unroll
    for (int j = 0; j < 4; ++j) { s0 += (v0[j].x * v0[j].x + v0[j].y * v0[j].y) + (v0[j].z * v0[j].z + v0[j].w * v0[j].w); s1 += (v1[j].x * v1[j].x + v1[j].y * v1[j].y) + (v1[j].z * v1[j].z + v1[j].w * v1[j].w); }
    const float r0 = rsqrtf(wave_sum(s0) * (1.f / DM) + RMS_EPS), r1 = rsqrtf(wave_sum(s1) * (1.f / DM) + RMS_EPS);
    u32x2* o0 = (u32x2*)orow0 + lane; u32x2* o1 = (u32x2*)orow1 + lane;
#pragma unroll
    for (int j = 0; j < 4; ++j) { const f32x4 gg = gr[64 * j]; u32x2 w;
        w.x = pk2(v0[j].x * r0 * gg.x, v0[j].y * r0 * gg.y); w.y = pk2(v0[j].z * r0 * gg.z, v0[j].w * r0 * gg.w); o0[64 * j] = w;
        w.x = pk2(v1[j].x * r1 * gg.x, v1[j].y * r1 * gg.y); w.y = pk2(v1[j].z * r1 * gg.z, v1[j].w * r1 * gg.w); o1[64 * j] = w; }
}
DI void rms_row_to_bf16(const float* xrow, const float* g, bf16* orow, int lane) {
    const f32x4* xr = (const f32x4*)xrow + lane; const f32x4* gr = (const f32x4*)g + lane;
    f32x4 v[4]; float s = 0.f;
#pragma unroll
    for (int j = 0; j < 4; ++j) { v[j] = xr[64 * j]; s += (v[j].x * v[j].x + v[j].y * v[j].y) + (v[j].z * v[j].z + v[j].w * v[j].w); }
    const float rstd = rsqrtf(wave_sum(s) * (1.f / DM) + RMS_EPS);
    u32x2* o8 = (u32x2*)orow + lane;
#pragma unroll
    for (int j = 0; j < 4; ++j) { const f32x4 gg = gr[64 * j]; u32x2 w; w.x = pk2(v[j].x * rstd * gg.x, v[j].y * rstd * gg.y); w.y = pk2(v[j].z * rstd * gg.z, v[j].w * rstd * gg.w); o8[64 * j] = w; }
}
DI void final_row(float* row, const float* g, float ssq, int lane) {
    f32x4* xr = (f32x4*)row + lane; const f32x4* gr = (const f32x4*)g + lane;
    const float rstd = rsqrtf(ssq * (1.f / DM) + RMS_EPS);
#pragma unroll
    for (int j = 0; j < 4; ++j) { f32x4 v = xr[64 * j]; const f32x4 gg = gr[64 * j]; v = v * rstd; v = v * gg; xr[64 * j] = v; }
}

constexpr int GL_P = 144;
constexpr int GL_QD = 0, GL_KI = 9216, GL_KDT = 18432, GL_VT = 27648, GL_DEC = 46080, GL_LR = 47104, GL_CL = 51200, GL_OB = 52224, GL_OBP = 272, GL_DIR = 52224 + 64 * 272;
constexpr int GSEG = 1024;
DI float fexp_(float x) { return __builtin_amdgcn_exp2f(1.4426950408889634f * x); }
DI float logsigmoid_(float x) { return fminf(x, 0.f) - 0.6931471805599453f * __builtin_amdgcn_logf(1.0f + fexp_(-fabsf(x))); }

DI void gla_pass1(LAS unsigned char* lds, const Args& A, const bf16* proj, bf16* scratch, bf16* QS, bf16* HT, float* DD, int T, int b, int h, int k, int tid_in) {
    int tid = tid_in; asm volatile("" : "+v"(tid));
    const int lane = tid & 63, wave = tid >> 6, dir = wave >> 2, c = wave & 3, d = lane, g = lane >> 4, l15 = lane & 15;
    LAS unsigned char* L = lds + dir * GL_DIR;
    constexpr int NI = GSEG / 64;
    const size_t rowb = (size_t)b * T + (size_t)k * GSEG;
    const int sidx = ((b * 4 + h) * (T / GSEG) + k) * 2 + dir;
    unsigned gkp[8];
#pragma unroll
    for (int j = 0; j < 8; ++j) gkp[j] = pk2(A.gk_w[dir][(2 * j) * 256 + h * 64 + d], A.gk_w[dir][(2 * j + 1) * 256 + h * 64 + d]);
    const float gkb = A.gk_b[dir][h * 64 + d];
    f32x4 S[4][2];
#pragma unroll
    for (int mt = 0; mt < 4; ++mt)
#pragma unroll
        for (int nt = 0; nt < 2; ++nt) S[mt][nt] = (f32x4){0.f, 0.f, 0.f, 0.f};
    const int vs = c * 32;
    const int tl = tid & 255;
    float carry = 0.f;
    unsigned short qraw[16], kraw[16]; u32x2 lrraw; u32x4 vraw[4];
#define GLA_ROW(s) (rowb + (size_t)(dir ? (GSEG - 1 - (s)) : (s)))
#define GLA_PREFETCH(it) do { const int s0_ = (it) * 64; \
        _Pragma("unroll") for (int i = 0; i < 16; ++i) { const bf16* p_ = proj + GLA_ROW(s0_ + c * 16 + i) * NP + h * 64 + d; qraw[i] = p_[C_GQ]; kraw[i] = p_[C_GK]; } \
        lrraw = *(const u32x2*)(proj + GLA_ROW(s0_ + c * 16 + (lane >> 2)) * NP + C_LR + dir * 16 + (lane & 3) * 4); \
        _Pragma("unroll") for (int q = 0; q < 4; ++q) { const int idx_ = tl + 256 * q; vraw[q] = *(const u32x4*)(proj + GLA_ROW(s0_ + (idx_ & 63)) * NP + C_GV + h * 128 + (idx_ >> 6) * 8); } } while (0)
#define GLA_FLUSH(itf) do { _Pragma("unroll") for (int q_ = 0; q_ < 4; ++q_) { const int idx_ = tl + 256 * q_, tk_ = idx_ >> 4, ch_ = idx_ & 15; \
        *(u32x4*)(scratch + GLA_ROW((itf) * 64 + tk_) * DM + dir * 512 + h * 128 + ch_ * 8) = *(const LAS u32x4*)(L + GL_OB + tk_ * GL_OBP + ch_ * 16); } } while (0)
    GLA_PREFETCH(0);
#pragma unroll 1
    for (int it = 0; it < NI; ++it) {
        BAR_LDS();
        if (it > 0) GLA_FLUSH(it - 1);
        *(LAS u32x2*)(L + GL_LR + (c * 16 + (lane >> 2)) * 32 + (lane & 3) * 8) = lrraw;
        LDS_WAIT();
        float qdv[16];
        {   float cum = 0.f; float kinv[16];
#pragma unroll
            for (int i = 0; i < 16; ++i) {
                const LAS u32x4* lr4 = (const LAS u32x4*)(L + GL_LR + (c * 16 + i) * 32);
                const u32x4 la_ = lr4[0], lb_ = lr4[1];
                const unsigned lw[8] = {la_.x, la_.y, la_.z, la_.w, lb_.x, lb_.y, lb_.z, lb_.w};
                float pre = gkb;
#pragma unroll
                for (int j = 0; j < 8; ++j) pre = __builtin_amdgcn_fdot2_f32_bf16(__builtin_bit_cast(bf16v2, lw[j]), __builtin_bit_cast(bf16v2, gkp[j]), pre, false);
                cum += logsigmoid_(pre) * (1.0f / 16.0f);
                const float e = fexp_(cum); qdv[i] = bf2f(qraw[i]) * e;
                kinv[i] = bf2f(kraw[i]) * __builtin_amdgcn_rcpf(e);
                *(LAS unsigned short*)(L + GL_QD + (c * 16 + i) * GL_P + d * 2) = f2bf(qdv[i]);
                *(LAS unsigned short*)(L + GL_KI + (c * 16 + i) * GL_P + d * 2) = f2bf(kinv[i]);
            }
            const float eL = fexp_(cum);
            ((LAS float*)(L + GL_DEC))[c * 64 + d] = eL;
            ((LAS float*)(L + GL_CL))[c * 64 + d] = cum;
            u32x4 w0, w1;
            w0.x = pk2(kinv[0] * eL, kinv[1] * eL); w0.y = pk2(kinv[2] * eL, kinv[3] * eL); w0.z = pk2(kinv[4] * eL, kinv[5] * eL); w0.w = pk2(kinv[6] * eL, kinv[7] * eL);
            w1.x = pk2(kinv[8] * eL, kinv[9] * eL); w1.y = pk2(kinv[10] * eL, kinv[11] * eL); w1.z = pk2(kinv[12] * eL, kinv[13] * eL); w1.w = pk2(kinv[14] * eL, kinv[15] * eL);
            *(LAS u32x4*)(L + GL_KDT + d * GL_P + c * 32) = w0; *(LAS u32x4*)(L + GL_KDT + d * GL_P + c * 32 + 16) = w1;
        }
#pragma unroll
        for (int q = 0; q < 4; ++q) { const int idx = tl + 256 * q, tk = idx & 63, v0 = (idx >> 6) * 8;
#pragma unroll
            for (int e = 0; e < 8; ++e) { const unsigned w = vraw[q][e >> 1]; *(LAS unsigned short*)(L + GL_VT + (v0 + e) * GL_P + tk * 2) = (unsigned short)((e & 1) ? (w >> 16) : (w & 0xffffu)); } }
        BAR_LDS();
        {   const LAS float* CL = (const LAS float*)(L + GL_CL) + d; const float c0 = CL[0], c1 = CL[64], c2 = CL[128], c3 = CL[192];
            const float off = carry + ((c > 0) ? c0 : 0.f) + ((c > 1) ? c1 : 0.f) + ((c > 2) ? c2 : 0.f);
            carry += (c0 + c1) + (c2 + c3);
            const float eo = fexp_(off);
#pragma unroll
            for (int i = 0; i < 16; ++i) QS[GLA_ROW(it * 64 + c * 16 + i) * 512 + dir * 256 + h * 64 + d] = f2bf(qdv[i] * eo); }
#pragma unroll
        for (int cc = 0; cc < 4; ++cc) {
            const int trow = cc * 16 + l15;
            f32x4 X = (f32x4){0.f, 0.f, 0.f, 0.f};
#pragma unroll
            for (int ks = 0; ks < 2; ++ks) { const bf16x8 ki = *(const LAS bf16x8*)(L + GL_KI + trow * GL_P + (ks * 32 + 8 * g) * 2), qd = *(const LAS bf16x8*)(L + GL_QD + trow * GL_P + (ks * 32 + 8 * g) * 2);
                X = MFMA32(ki, qd, X); }
#pragma unroll
            for (int r = 0; r < 4; ++r) if (4 * g + r > l15) X[r] = 0.f;
            u32x2 pp; pp.x = pk2(X[0], X[1]); pp.y = pk2(X[2], X[3]);
            const s16x4 P = __builtin_bit_cast(s16x4, pp);
            s16x4 vt[2]; f32x4 o[2];
#pragma unroll
            for (int nt = 0; nt < 2; ++nt) { vt[nt] = *(const LAS s16x4*)(L + GL_VT + (vs + 16 * nt + l15) * GL_P + (cc * 16 + 4 * g) * 2);
                o[nt] = MFMA16(P, vt[nt], ((f32x4){0.f, 0.f, 0.f, 0.f})); }
#pragma unroll
            for (int ks = 0; ks < 2; ++ks) {
                const u32x2 qlo = *(const LAS u32x2*)(L + GL_QD + trow * GL_P + (32 * ks + 4 * g) * 2), qhi = *(const LAS u32x2*)(L + GL_QD + trow * GL_P + (32 * ks + 16 + 4 * g) * 2);
                const u32x4 qq = (u32x4){qlo.x, qlo.y, qhi.x, qhi.y}; const bf16x8 qa = __builtin_bit_cast(bf16x8, qq);
#pragma unroll
                for (int nt = 0; nt < 2; ++nt) { const f32x4 s0 = S[2 * ks][nt], s1 = S[2 * ks + 1][nt];
                    const u32x4 sw = (u32x4){pk2(s0[0], s0[1]), pk2(s0[2], s0[3]), pk2(s1[0], s1[1]), pk2(s1[2], s1[3])};
                    o[nt] = MFMA32(qa, __builtin_bit_cast(bf16x8, sw), o[nt]); } }
#pragma unroll
            for (int r = 0; r < 4; ++r) { LAS unsigned short* op = (LAS unsigned short*)(L + GL_OB + (cc * 16 + 4 * g + r) * GL_OBP + (vs + l15) * 2); op[0] = f2bf(o[0][r]); op[16] = f2bf(o[1][r]); }
#pragma unroll
            for (int mt = 0; mt < 4; ++mt) { const f32x4 dec = *(const LAS f32x4*)(L + GL_DEC + (cc * 64 + 16 * mt + 4 * g) * 4);
                const s16x4 kd = *(const LAS s16x4*)(L + GL_KDT + (16 * mt + l15) * GL_P + (cc * 16 + 4 * g) * 2);
#pragma unroll
                for (int nt = 0; nt < 2; ++nt) { f32x4 sv = S[mt][nt]; sv = sv * dec; S[mt][nt] = MFMA16(kd, vt[nt], sv); } }
            if (cc == 1 && it + 1 < NI) GLA_PREFETCH(it + 1);
        }
    }
    BAR_LDS();
    GLA_FLUSH(NI - 1);
#undef GLA_FLUSH
#undef GLA_PREFETCH
#undef GLA_ROW
#pragma unroll
    for (int mt = 0; mt < 4; ++mt)
#pragma unroll
        for (int nt = 0; nt < 2; ++nt) { u32x2 w; w.x = pk2(S[mt][nt][0], S[mt][nt][1]); w.y = pk2(S[mt][nt][2], S[mt][nt][3]);
            *(u32x2*)(HT + ((size_t)sidx * 128 + vs + 16 * nt + l15) * 64 + 16 * mt + 4 * g) = w; }
    if (c == 0) DD[(size_t)sidx * 64 + d] = fexp_(carry);
    __syncthreads();
}

constexpr int G2_S0 = 0, G2_OT = 36864, G2_OTP = 132;
DI void gla_pass2(LAS unsigned char* lds, const Args& A, const bf16* proj, const bf16* scratch, const bf16* QS, const bf16* HT, const float* DD, bf16* glao, int T, int b, int h, int k, int tid_in) {
    int tid = tid_in; asm volatile("" : "+v"(tid));
    const int lane = tid & 63, wave = tid >> 6, g = lane >> 4, l15 = lane & 15;
    const int nseg = T / GSEG;
    const size_t rowb = (size_t)b * T + (size_t)k * GSEG;
    const int ntk = tid >> 3, nvc = tid & 7;
    bf16x8 AF[4][2][2]; u32x4 SC[2][2]; u32x4 gw[2];
#define G2_LOAD(grp) do { _Pragma("unroll") for (int mt_ = 0; mt_ < 4; ++mt_) { const size_t r0_ = rowb + (grp) * 64 + mt_ * 16; \
        _Pragma("unroll") for (int dir_ = 0; dir_ < 2; ++dir_) _Pragma("unroll") for (int ks_ = 0; ks_ < 2; ++ks_) AF[mt_][dir_][ks_] = *(const bf16x8*)(QS + (r0_ + l15) * 512 + dir_ * 256 + h * 64 + ks_ * 32 + 8 * g); \
        } \
        { const u32x4* gp_ = (const u32x4*)(proj + (rowb + (grp) * 64 + ntk) * NP + C_GG + h * 128 + nvc * 16); gw[0] = gp_[0]; gw[1] = gp_[1]; \
          const u32x4* sp_ = (const u32x4*)(scratch + (rowb + (grp) * 64 + ntk) * DM + h * 128 + nvc * 16); SC[0][0] = sp_[0]; SC[0][1] = sp_[1]; SC[1][0] = sp_[64]; SC[1][1] = sp_[65]; } } while (0)
    G2_LOAD(0);
    {   const int dir = tid >> 8, oct = tid & 7, vq = (tid & 255) >> 3;
        float acc[4][8], w[8];
#pragma unroll
        for (int e = 0; e < 8; ++e) { w[e] = 1.f;
#pragma unroll
            for (int j = 0; j < 4; ++j) acc[j][e] = 0.f; }
        const int nsteps = dir ? (nseg - 1 - k) : k;
        const int sbase = ((b * 4 + h) * nseg) * 2 + dir, mstep = dir ? 2 : -2;
        int si = sbase + 2 * (dir ? (k + 1) : (k - 1));
        u32x4 hc[4]; f32x4 dc[2];
#define G2_LDH(sidx, hh, dd) do { _Pragma("unroll") for (int j_ = 0; j_ < 4; ++j_) hh[j_] = *(const u32x4*)(HT + ((size_t)(sidx) * 128 + vq + 32 * j_) * 64 + oct * 8); \
        dd[0] = *(const f32x4*)(DD + (size_t)(sidx) * 64 + oct * 8); dd[1] = *(const f32x4*)(DD + (size_t)(sidx) * 64 + oct * 8 + 4); } while (0)
        if (nsteps > 0) G2_LDH(si, hc, dc);
#pragma unroll 1
        for (int st = 0; st < nsteps; ++st) {
            u32x4 hn[4]; f32x4 dn[2];
#pragma unroll
            for (int j = 0; j < 4; ++j) hn[j] = hc[j];
            dn[0] = dc[0]; dn[1] = dc[1];
            si += mstep;
            if (st + 1 < nsteps) G2_LDH(si, hn, dn);
#pragma unroll
            for (int j = 0; j < 4; ++j)
#pragma unroll
                for (int e = 0; e < 8; ++e) { const unsigned x = hc[j][e >> 1]; const float hv = (e & 1) ? __uint_as_float(x & 0xffff0000u) : __uint_as_float(x << 16); acc[j][e] += w[e] * hv; }
#pragma unroll
            for (int e = 0; e < 8; ++e) w[e] *= (e < 4) ? dc[0][e & 3] : dc[1][e & 3];
#pragma unroll
            for (int j = 0; j < 4; ++j) hc[j] = hn[j];
            dc[0] = dn[0]; dc[1] = dn[1];
        }
#undef G2_LDH
#pragma unroll
        for (int j = 0; j < 4; ++j) *(LAS u32x4*)(lds + G2_S0 + dir * 18432 + (vq + 32 * j) * GL_P + oct * 16) =
            (u32x4){pk2(acc[j][0], acc[j][1]), pk2(acc[j][2], acc[j][3]), pk2(acc[j][4], acc[j][5]), pk2(acc[j][6], acc[j][7])};
    }
    BAR_LDS();
    bf16x8 Bf[2][2];
#pragma unroll
    for (int dir = 0; dir < 2; ++dir)
#pragma unroll
        for (int ks = 0; ks < 2; ++ks) Bf[dir][ks] = *(const LAS bf16x8*)(lds + G2_S0 + dir * 18432 + (16 * wave + l15) * GL_P + (ks * 32 + 8 * g) * 2);
    LAS float* OT = (LAS float*)(lds + G2_OT);
    f32x4 gn[4];
#pragma unroll
    for (int j = 0; j < 4; ++j) gn[j] = *(const f32x4*)(A.gla_norm_g + nvc * 16 + 4 * j);
#pragma unroll 1
    for (int grp = 0; grp < GSEG / 64; ++grp) {
#pragma unroll
        for (int mtile = 0; mtile < 4; ++mtile) {
            f32x4 acc = (f32x4){0.f, 0.f, 0.f, 0.f};
#pragma unroll
            for (int dir = 0; dir < 2; ++dir)
#pragma unroll
                for (int ks = 0; ks < 2; ++ks) acc = MFMA32(AF[mtile][dir][ks], Bf[dir][ks], acc);
#pragma unroll
            for (int r = 0; r < 4; ++r) OT[(mtile * 16 + 4 * g + r) * G2_OTP + 16 * wave + l15] = acc[r];
        }
        const u32x4 gw0 = gw[0], gw1 = gw[1], sf0 = SC[0][0], sf1 = SC[0][1], sb0 = SC[1][0], sb1 = SC[1][1];
        if (grp + 1 < GSEG / 64) G2_LOAD(grp + 1);
        BAR_LDS();
        {   const size_t row = rowb + grp * 64 + ntk; f32x4 sv[4]; float ss = 0.f;
#pragma unroll
            for (int j = 0; j < 4; ++j) { const u32x4 cf = (j < 2) ? sf0 : sf1, cb = (j < 2) ? sb0 : sb1; const unsigned f0 = cf[2 * (j & 1)], f1 = cf[2 * (j & 1) + 1], b0 = cb[2 * (j & 1)], b1 = cb[2 * (j & 1) + 1];
                f32x4 lo; lo.x = __uint_as_float(f0 << 16) + __uint_as_float(b0 << 16); lo.y = __uint_as_float(f0 & 0xffff0000u) + __uint_as_float(b0 & 0xffff0000u);
                lo.z = __uint_as_float(f1 << 16) + __uint_as_float(b1 << 16); lo.w = __uint_as_float(f1 & 0xffff0000u) + __uint_as_float(b1 & 0xffff0000u);
                sv[j] = *(const LAS f32x4*)(OT + ntk * G2_OTP + nvc * 16 + 4 * j) + lo; ss += (sv[j].x * sv[j].x + sv[j].y * sv[j].y) + (sv[j].z * sv[j].z + sv[j].w * sv[j].w); }
            ss += __shfl_xor(ss, 1); ss += __shfl_xor(ss, 2); ss += __shfl_xor(ss, 4);
            const float rstd = rsqrtf(ss * (1.0f / 128.0f) + RMS_EPS);
            u32x4* op = (u32x4*)(glao + row * DM + h * 128 + nvc * 16);
#pragma unroll
            for (int j2 = 0; j2 < 2; ++j2) { const u32x4 gq = j2 ? gw1 : gw0; const f32x4 a = sv[2 * j2] * rstd * gn[2 * j2], bb = sv[2 * j2 + 1] * rstd * gn[2 * j2 + 1];
                u32x4 w;
                w.x = pk2(a.x * __uint_as_float(gq.x << 16), a.y * __uint_as_float(gq.x & 0xffff0000u)); w.y = pk2(a.z * __uint_as_float(gq.y << 16), a.w * __uint_as_float(gq.y & 0xffff0000u));
                w.z = pk2(bb.x * __uint_as_float(gq.z << 16), bb.y * __uint_as_float(gq.z & 0xffff0000u)); w.w = pk2(bb.z * __uint_as_float(gq.w << 16), bb.w * __uint_as_float(gq.w & 0xffff0000u));
                op[j2] = w; }
        }
        BAR_LDS();
    }
#undef G2_LOAD
}

constexpr int NA_K = 0, NA_V = 65536, NA_MRG = 131072, NA_BIAS = 131072 + 18432, NA_ITEM = NA_BIAS + 1920;
static_assert(NA_ITEM + 64 <= LDS_BYTES, "NA LDS map");
DI void na_phase(LAS unsigned char* lds, const Args& A, const bf16* proj, bf16* nao, int T, int nB, unsigned* counter, int tid_in) {
    int tid = tid_in; asm volatile("" : "+v"(tid));
    const int lane = tid & 63, wave = tid >> 6, qg = wave & 3, kh = wave >> 2, g = lane >> 4, l15 = lane & 15;
    constexpr int NAR = 32;
    const int rows = T / 64, nr = rows / NAR, nitems = nB * 8 * nr;
    const int cq = 16 * qg + l15;
    const int cs0 = (qg == 0) ? 0 : ((qg == 1) ? 8 : ((qg == 2) ? 24 : 32));
    const int csq = min(max(cq - 8, 0), 48);
    const int lc = tid >> 3, lc8 = tid & 7;
    for (;;) {
        if (tid == 0) *(LAS unsigned*)(lds + NA_ITEM) = atomicAdd(counter, 1u);
        __syncthreads();
        const int item = (int)*(LAS unsigned*)(lds + NA_ITEM);
        if (item >= nitems) break;
        const int b = item / (8 * nr), h = (item / nr) & 7, r0 = (item % nr) * NAR;
        const size_t rowb = (size_t)b * T;
        if (tid < 465) ((LAS float*)(lds + NA_BIAS))[tid] = A.na_rpb[h * 465 + tid];
#define NA_RS(r) min(max((r) - 4, 0), rows - 8)
#define NA_LOADROW(kr, kreg, vreg) do { const bf16* p_ = proj + (rowb + (size_t)(kr) * 64 + lc) * NP + h * 64 + lc8 * 8; kreg = *(const u32x4*)(p_ + C_NAK); vreg = *(const u32x4*)(p_ + C_NAV); } while (0)
#define NA_STOREROW(kr, kreg, vreg) do { const int sl_ = (kr) & 7; \
            *(LAS u32x4*)(lds + NA_K + sl_ * 8192 + lc * 128 + ((lc8 ^ ((lc >> 1) & 7)) * 16)) = kreg; \
            _Pragma("unroll") for (int e = 0; e < 8; ++e) { const int d_ = lc8 * 8 + e; const unsigned w_ = vreg[e >> 1]; \
                *(LAS unsigned short*)(lds + NA_V + sl_ * 8192 + d_ * 128 + (((lc >> 2) ^ (2 * ((d_ >> 1) & 7))) * 8) + (lc & 3) * 2) = (unsigned short)((e & 1) ? (w_ >> 16) : (w_ & 0xffffu)); } } while (0)
        {   const int rs0 = NA_RS(r0); u32x4 kr8[8], vr8[8];
#pragma unroll
            for (int i = 0; i < 8; ++i) NA_LOADROW(rs0 + i, kr8[i], vr8[i]);
#pragma unroll
            for (int i = 0; i < 8; ++i) NA_STOREROW(rs0 + i, kr8[i], vr8[i]); }
        bf16x8 qf[2], qn[2];
#define NA_LOADQ(r, dst) do { const bf16* p_ = proj + (rowb + (size_t)(r) * 64 + cq) * NP + C_NAQ + h * 64 + 8 * g; dst[0] = *(const bf16x8*)p_; dst[1] = *(const bf16x8*)(p_ + 32); } while (0)
        NA_LOADQ(r0, qf);
        __syncthreads();
#pragma unroll 1
        for (int r = r0; r < r0 + NAR; ++r) {
            const int rs = NA_RS(r);
            const bool more = (r + 1 < r0 + NAR), need_new = more && (NA_RS(r + 1) != rs);
            u32x4 kreg = (u32x4){0u, 0u, 0u, 0u}, vreg = (u32x4){0u, 0u, 0u, 0u};
            if (need_new) NA_LOADROW(rs + 8, kreg, vreg);
            if (more) NA_LOADQ(r + 1, qn);
            f32x4 sT[4][2]; float mx = -INFINITY;
            const LAS float* BI = (const LAS float*)(lds + NA_BIAS);
#pragma unroll
            for (int rr = 0; rr < 4; ++rr) { const int kr = rs + 4 * kh + rr, sl = kr & 7;
#pragma unroll
                for (int ct = 0; ct < 2; ++ct) { const int cm = cs0 + 16 * ct + l15; f32x4 acc = (f32x4){0.f, 0.f, 0.f, 0.f};
#pragma unroll
                    for (int ks = 0; ks < 2; ++ks) { const bf16x8 kf = *(const LAS bf16x8*)(lds + NA_K + sl * 8192 + cm * 128 + (((4 * ks + g) ^ ((cm >> 1) & 7)) * 16)); acc = MFMA32(kf, qf[ks], acc); }
#pragma unroll
                    for (int e = 0; e < 4; ++e) { const int cc = cs0 + 16 * ct + 4 * g + e; const bool valid = (cc >= csq) && (cc < csq + 16);
                        const int bi = (kr - r + 7) * 31 + min(max(cc - cq + 15, 0), 30);
                        const float sv = valid ? acc[e] + BI[bi] : -INFINITY; acc[e] = sv; mx = fmaxf(mx, sv); }
                    sT[rr][ct] = acc; } }
            mx = fmaxf(mx, __shfl_xor(mx, 16)); mx = fmaxf(mx, __shfl_xor(mx, 32));
            float lsum = 0.f;
#pragma unroll
            for (int rr = 0; rr < 4; ++rr)
#pragma unroll
                for (int ct = 0; ct < 2; ++ct)
#pragma unroll
                    for (int e = 0; e < 4; ++e) { const float p = __expf(sT[rr][ct][e] - mx); sT[rr][ct][e] = p; lsum += p; }
            lsum += __shfl_xor(lsum, 16); lsum += __shfl_xor(lsum, 32);
            f32x4 O[4];
#pragma unroll
            for (int mt = 0; mt < 4; ++mt) O[mt] = (f32x4){0.f, 0.f, 0.f, 0.f};
#pragma unroll
            for (int rr = 0; rr < 4; ++rr) { const int sl = (rs + 4 * kh + rr) & 7;
                const u32x4 pw = (u32x4){pk2(sT[rr][0][0], sT[rr][0][1]), pk2(sT[rr][0][2], sT[rr][0][3]), pk2(sT[rr][1][0], sT[rr][1][1]), pk2(sT[rr][1][2], sT[rr][1][3])};
                const bf16x8 pb = __builtin_bit_cast(bf16x8, pw);
#pragma unroll
                for (int mt = 0; mt < 4; ++mt) { const int dd = 16 * mt + l15, sw = 2 * ((dd >> 1) & 7);
                    const LAS unsigned char* vb = lds + NA_V + sl * 8192 + dd * 128;
                    const u32x2 lo = *(const LAS u32x2*)(vb + ((((cs0 >> 2) + g) ^ sw) * 8)), hi = *(const LAS u32x2*)(vb + ((((cs0 >> 2) + 4 + g) ^ sw) * 8));
                    const u32x4 vv = (u32x4){lo.x, lo.y, hi.x, hi.y};
                    O[mt] = MFMA32(__builtin_bit_cast(bf16x8, vv), pb, O[mt]); } }
            LAS float* MG = (LAS float*)(lds + NA_MRG + qg * 4608) + lane;
            if (kh == 1) { MG[0] = mx; MG[64] = lsum;
#pragma unroll
                for (int mt = 0; mt < 4; ++mt)
#pragma unroll
                    for (int e = 0; e < 4; ++e) MG[(2 + mt * 4 + e) * 64] = O[mt][e]; }
            __syncthreads();
            if (kh == 0) { const float m1 = MG[0], l1 = MG[64], M = fmaxf(mx, m1), a0 = __expf(mx - M), a1 = __expf(m1 - M), inv = 1.0f / (lsum * a0 + l1 * a1);
                bf16* op = nao + (rowb + (size_t)r * 64 + cq) * DM + h * 64 + 4 * g;
#pragma unroll
                for (int mt = 0; mt < 4; ++mt) { float v[4];
#pragma unroll
                    for (int e = 0; e < 4; ++e) v[e] = (O[mt][e] * a0 + MG[(2 + mt * 4 + e) * 64] * a1) * inv;
                    u32x2 w; w.x = pk2(v[0], v[1]); w.y = pk2(v[2], v[3]); *(u32x2*)(op + 16 * mt) = w; } }
            if (need_new) NA_STOREROW(rs + 8, kreg, vreg);
            if (more) { qf[0] = qn[0]; qf[1] = qn[1]; }
            __syncthreads();
        }
#undef NA_RS
#undef NA_LOADROW
#undef NA_STOREROW
#undef NA_LOADQ
    }
    __syncthreads();
}

#define XB_TMO      128
#define XB_XCNT(j)  (256  + 64 * (j))
#define XB_XSUB(j)  (1280 + 64 * (j))
#define XB_XGEN(j)  (2304 + 64 * (j))
#define XB_TOP      3328
#define XB_TOPGEN   3392
#define XCD_BAR_WORDS 3456
#define XB_SPIN_CAP (1u << 18)

__device__ __forceinline__ unsigned xb_ld(unsigned* p)              { return __hip_atomic_load(p, __ATOMIC_RELAXED, __HIP_MEMORY_SCOPE_AGENT); }
__device__ __forceinline__ unsigned xb_add(unsigned* p, unsigned v) { return __hip_atomic_fetch_add(p, v, __ATOMIC_RELAXED, __HIP_MEMORY_SCOPE_AGENT); }
__device__ __forceinline__ unsigned xb_xcc_id() { return (unsigned)__builtin_amdgcn_s_getreg((3 << 11) | 20) & 0xFu; }
#define XB_SPIN(cond, bar) do { unsigned _sp = 0; while (cond) { __builtin_amdgcn_s_sleep(1); \
    if ((++_sp & 255u) == 0u) { if (xb_ld(&(bar)[XB_TMO])) break; if (_sp > XB_SPIN_CAP) { atomicAdd(&(bar)[XB_TMO], 1u); break; } } } } while (0)

struct XcdBarrier {
    unsigned* bar; unsigned x;
    volatile LAS unsigned* st;
};

__device__ __forceinline__ XcdBarrier xcd_barrier_post(unsigned* bar, volatile LAS unsigned* st) {
    XcdBarrier b; b.bar = bar; b.x = xb_xcc_id(); b.st = st;
    if (threadIdx.x == 0) (void)xb_add(&bar[XB_XCNT(b.x)], 1u);
    return b;
}
__device__ __forceinline__ void xcd_barrier_complete(unsigned* bar, unsigned x, unsigned& nloc, unsigned& nx) {
    const unsigned G = gridDim.x * gridDim.y * gridDim.z;
    unsigned sum, cnt, mine, sp = 0u;
    for (;;) {
        sum = 0u; cnt = 0u; mine = 0u;
#pragma unroll
        for (unsigned j = 0; j < 16; ++j) { const unsigned c = xb_ld(&bar[XB_XCNT(j)]); sum += c; cnt += (c > 0u) ? 1u : 0u; mine = (j == x) ? c : mine; }
        if (sum == G) break;
        __builtin_amdgcn_s_sleep(1);
        if ((++sp & 255u) == 0u) { if (xb_ld(&bar[XB_TMO])) break; if (sp > XB_SPIN_CAP) { atomicAdd(&bar[XB_TMO], 1u); break; } }
    }
    nloc = mine > 0u ? mine : 1u; nx = cnt > 0u ? cnt : 1u;
}

__device__ __forceinline__ void xcd_barrier(const XcdBarrier& b) {
    asm volatile("s_waitcnt vmcnt(0)" ::: "memory");
    __syncthreads();
    if (threadIdx.x == 0) {
        unsigned* bar = b.bar;
        __builtin_amdgcn_s_waitcnt(0);
        unsigned nloc = b.st[0], nx = b.st[1];
        if (nloc == 0u) { xcd_barrier_complete(bar, b.x, nloc, nx); b.st[0] = nloc; b.st[1] = nx; }
        const unsigned old = xb_add(&bar[XB_XSUB(b.x)], 1u);
        const unsigned gen = old / nloc;
        if (old + 1u == (gen + 1u) * nloc) {
            __builtin_amdgcn_fence(__ATOMIC_RELEASE, "agent");
            asm volatile("s_waitcnt vmcnt(0)" ::: "memory");
            const unsigned og = xb_add(&bar[XB_TOP], 1u);
            const unsigned tg = og / nx;
            if (og + 1u == (tg + 1u) * nx) xb_add(&bar[XB_TOPGEN], 1u);
            else XB_SPIN(xb_ld(&bar[XB_TOPGEN]) == tg, bar);
            __builtin_amdgcn_fence(__ATOMIC_ACQUIRE, "agent");
            xb_add(&bar[XB_XGEN(b.x)], 1u);
            asm volatile("s_waitcnt vmcnt(0)" ::: "memory");
        } else {
            XB_SPIN(xb_ld(&bar[XB_XGEN(b.x)]) == gen, bar);
            __builtin_amdgcn_fence(__ATOMIC_ACQUIRE, "agent");
            asm volatile("s_waitcnt vmcnt(0)" ::: "memory");
        }
    }
    __syncthreads();
}

constexpr int N_PHASES = 15;
__global__ void __launch_bounds__(NTHR, 2) fwd_kernel(Args A) {
    extern __shared__ __attribute__((aligned(16))) unsigned char lds_raw[];
    LAS unsigned char* lds = (LAS unsigned char*)lds_raw;
    const int tid = threadIdx.x, lane = tid & 63, wave = __builtin_amdgcn_readfirstlane(tid >> 6);
    const int G = gridDim.x, bx = blockIdx.x;
    unsigned char* ws = A.ws;
#define Wt_in ((bf16*)(ws + WS_WIN))
#define Wt_na ((bf16*)(ws + WS_WNA))
#define Wt_gla ((bf16*)(ws + WS_WGLA))
#define Wt_out ((bf16*)(ws + WS_WOUT))
#define Wt_up ((bf16*)(ws + WS_WUP))
#define Wt_down ((bf16*)(ws + WS_WDOWN))
#define biasp ((float*)(ws + WS_BIAS))
#define U ((bf16*)(ws + WS_U))
#define NAO ((bf16*)(ws + WS_NAO))
#define GLAO ((bf16*)(ws + WS_NAO) + 512)
#define HB ((bf16*)(ws + WS_NAO))
#define PROJ ((bf16*)(ws + WS_PROJ))
#define HDN ((bf16*)(ws + WS_PROJ))
#define ctl ((unsigned*)(ws + WS_CTL))
    const int gw = bx * NWAVES + wave, NGW = G * NWAVES;
    const int lo = A.ph_lo, hi = A.ph_hi;
#ifndef PH_MASK
#define PH_MASK 0x1ff
#endif
#define PHM(b) ((PH_MASK >> (b)) & 1)
#define IN(k) (lo <= (k) && (k) < hi)
    if (tid < 2) ((volatile LAS unsigned*)(lds + LDS_BYTES - 64))[tid] = 0u;
    __syncthreads();
    XcdBarrier xbar; xbar.bar = ctl + 4096; xbar.x = 0; xbar.st = nullptr;
    if (A.coop) xbar = xcd_barrier_post(ctl + 4096, (volatile LAS unsigned*)(lds + LDS_BYTES - 64));
#define SEAM(k) do { if (IN(k) && IN((k) + 1)) { if (A.pad == 0x7fffffff) cg::this_grid().sync(); else xcd_barrier(xbar); } } while (0)

    if (PHM(0) && IN(0)) {
        LAS float* scr = (LAS float*)(lds + wave * 16384);
        constexpr int I_IN = (DM / 64) * (5152 / 32), I_BR = (512 / 64) * (DM / 32), I_OUT = (DM / 64) * (DM / 32), I_UP = (DM / 64) * (DFF / 32), I_DN = (DFF / 64) * (DM / 32);
        constexpr int NITEMS = I_IN + 2 * I_BR + I_OUT + I_UP + I_DN;
        for (int pass = 0; pass < 2; ++pass) {
        if ((pass ^ (wave & 1)) == 0) {
        for (int it = gw; it < NITEMS; it += NGW) {
            int r = it;
            if (r < I_IN) { transpose_item<1>(A.w_in, DM, 5152, Wt_in, scr, r, lane, nullptr); continue; } r -= I_IN;
            if (r < I_BR) { transpose_item<0>(A.w_br_na, 512, DM, Wt_na, scr, r, lane, nullptr, DM, 0); continue; } r -= I_BR;
            if (r < I_BR) { transpose_item<0>(A.w_br_gla, 512, DM, Wt_na, scr, r, lane, nullptr, DM, 512); continue; } r -= I_BR;
            if (r < I_OUT) { transpose_item<0>(A.w_out, DM, DM, Wt_out, scr, r, lane, nullptr); continue; } r -= I_OUT;
            if (r < I_UP) { transpose_item<2>(A.w_up, DM, DFF, Wt_up, scr, r, lane, A.norm_mlp_g); continue; } r -= I_UP;
            transpose_item<3>(A.w_down, DFF, DM, Wt_down, scr, r, lane, nullptr);
        }
        } else {
        for (int m = gw; m < SBTOK; m += NGW) rms_row2_to_bf16(A.x[0] + (size_t)m * DM, A.x[1] + (size_t)m * DM, A.norm_mix_g, U + (size_t)m * DM, (bf16*)(A.out + (size_t)SBTOK * DM) + (size_t)m * DM, lane);
        }
        }
        {   const int gt = bx * NTHR + tid, NGT = G * NTHR;
            u32x4* zp = (u32x4*)(Wt_in + (size_t)5152 * DM);
            for (int i = gt; i < 224 * DM * 2 / 16; i += NGT) zp[i] = (u32x4){0u, 0u, 0u, 0u};
            for (int n = gt; n < NP; n += NGT) { float v = 0.f; if (n < 3072) v = A.b_in[n]; else if (n < C_LR) v = A.b_in[n + 32]; else if (n < C_LR + 32) v = A.b_in[3072 + (n - C_LR)]; biasp[n] = v; } }
        __syncthreads();
    }
    SEAM(0);

#pragma unroll 1
    for (int sb = 0; sb < 2; ++sb) {
        const int P = 1 + 7 * sb;
        const int T = sb ? 4096 : 2048, nB = sb ? 16 : 32;
        const float* xsb = A.x[sb]; float* outsb = A.out + (size_t)sb * SBTOK * DM;
        float* ssq1 = (float*)(ws + WS_SSQ1) + sb * SBTOK; float* ssq2 = (float*)(ws + WS_SSQ2) + sb * SBTOK;
        if (PHM(1) && IN(P)) { pg8::Gemm g{sb ? (const bf16*)outsb : (const bf16*)U, Wt_in, SBTOK, NP, DM}; pg8::StaticOrder S; S.init(SBTOK, NP, G, bx);
            pg8::EpiProj E{PROJ, biasp};
            pg8::gemm_phase<pg8::EpiProj, pg8::StaticOrder, true, true>(lds, g, S, E); }
        SEAM(P);
        bf16* QS = (bf16*)(ws + WS_U); bf16* HT = (bf16*)(ws + WS_U + 64 * MiB); float* DD = (float*)(ws + WS_U + 96 * MiB);
        const int nseg = T / GSEG, ngla = nB * 4 * nseg;
        if (IN(P + 1)) {
            if (PHM(2)) for (int item = bx; item < ngla; item += G) gla_pass1(lds, A, PROJ, (bf16*)outsb, QS, HT, DD, T, item / (4 * nseg), (item / nseg) & 3, item % nseg, tid);
            if (PHM(3)) na_phase(lds, A, PROJ, NAO, T, nB, ctl + 64 * (1 + sb), tid);
        }
        SEAM(P + 1);
        if (IN(P + 2)) {
            if (PHM(2)) for (int item = bx; item < ngla; item += G) gla_pass2(lds, A, PROJ, (const bf16*)outsb, QS, HT, DD, GLAO, T, item / (4 * nseg), (item / nseg) & 3, item % nseg, tid);
        }
        SEAM(P + 2);
        if (PHM(4) && IN(P + 3)) { pg8::Gemm g{NAO, Wt_na, SBTOK, DM, DM}; pg8::StaticOrder S; S.init(SBTOK, DM, G, bx); pg8::EpiBranchFused E{PROJ, U};
            pg8::gemm_phase<pg8::EpiBranchFused, pg8::StaticOrder, true, true>(lds, g, S, E); }
        SEAM(P + 3);
        if (PHM(5) && IN(P + 4)) { pg8::Gemm g{U, Wt_out, SBTOK, DM, DM}; pg8::StaticOrder S; S.init(SBTOK, DM, G, bx);
            pg8::EpiOut E{xsb, HB, ssq1};
            pg8::gemm_phase<pg8::EpiOut, pg8::StaticOrder, true, true>(lds, g, S, E); }
        SEAM(P + 4);
        if (PHM(6) && IN(P + 5)) { pg8::Gemm g{HB, Wt_up, SBTOK, DFF, DM}; pg8::StaticOrder S; S.init(SBTOK, DFF, G, bx);
            pg8::EpiUp E{ssq1, HDN};
            pg8::gemm_phase<pg8::EpiUp, pg8::StaticOrder, true, true>(lds, g, S, E); }
        SEAM(P + 5);
        if (PHM(7) && IN(P + 6)) { pg8::Gemm g{HDN, Wt_down, SBTOK, DM, DFF}; pg8::StaticOrder S; S.init(SBTOK, DM, G, bx);
            pg8::EpiDownNorm E{HB, outsb, ssq2, ctl + 1024 + sb * 256, A.norm_final_g};
            pg8::gemm_phase<pg8::EpiDownNorm, pg8::StaticOrder, true, true, true>(lds, g, S, E); }
        if (sb == 0) SEAM(P + 6);
    }
#undef IN
#undef SEAM
}

extern "C" void kernel_launch(void* const* d_in, const int* in_sizes, int n_in, void* d_out, int out_size, void* d_ws, size_t ws_size, hipStream_t stream) {
    static int grid = 0;
    if (grid == 0) {
        if (n_in != 18 || ws_size < WS_END) { fprintf(stderr, "kernel_launch: unexpected n_in %d / ws_size %zu\n", n_in, ws_size); grid = -1; return; }
        int dev = 0, cus = 0, per_cu = 0;
        hipGetDevice(&dev); hipDeviceGetAttribute(&cus, hipDeviceAttributeMultiprocessorCount, dev);
        if (hipFuncSetAttribute((const void*)fwd_kernel, hipFuncAttributeMaxDynamicSharedMemorySize, LDS_BYTES) != hipSuccess) { fprintf(stderr, "kernel_launch: hipFuncSetAttribute failed\n"); grid = -1; return; }
        if (hipOccupancyMaxActiveBlocksPerMultiprocessor(&per_cu, (const void*)fwd_kernel, NTHR, LDS_BYTES) != hipSuccess || per_cu < 1) { fprintf(stderr, "kernel_launch: occupancy query says %d\n", per_cu); per_cu = 1; }
        (void)hipGetLastError();
        grid = cus * per_cu;
    }
    if (grid < 0) return;
    hipMemsetAsync((char*)d_ws + WS_CTL, 0, CTL_BYTES, stream);
    Args a{};
    a.x[0] = (const float*)d_in[0]; a.x[1] = (const float*)d_in[1]; a.norm_mix_g = (const float*)d_in[2]; a.w_in = (const float*)d_in[3]; a.b_in = (const float*)d_in[4];
    a.na_rpb = (const float*)d_in[5]; a.gk_w[0] = (const float*)d_in[6]; a.gk_b[0] = (const float*)d_in[7]; a.gk_w[1] = (const float*)d_in[8]; a.gk_b[1] = (const float*)d_in[9];
    a.gla_norm_g = (const float*)d_in[10]; a.w_br_na = (const float*)d_in[11]; a.w_br_gla = (const float*)d_in[12]; a.w_out = (const float*)d_in[13];
    a.norm_mlp_g = (const float*)d_in[14]; a.w_up = (const float*)d_in[15]; a.w_down = (const float*)d_in[16]; a.norm_final_g = (const float*)d_in[17];
    a.out = (float*)d_out; a.ws = (unsigned char*)d_ws;
#if MK_SINGLE
    a.ph_lo = 0; a.ph_hi = N_PHASES; a.coop = 1;
    void* args[] = {&a};
    hipError_t e = hipLaunchCooperativeKernel((const void*)fwd_kernel, dim3(grid), dim3(NTHR), args, LDS_BYTES, stream);
    if (e != hipSuccess) fprintf(stderr, "cooperative launch failed: %s (grid %d)\n", hipGetErrorString(e), grid);
#else
    for (int p = 0; p < N_PHASES; ++p) { a.ph_lo = p; a.ph_hi = p + 1; a.coop = 0;
        hipLaunchKernelGGL(fwd_kernel, dim3(grid), dim3(NTHR), LDS_BYTES, stream, a); }
#endif
}
```

```cpp
#include <hip/hip_runtime.h>
#include <hip/hip_cooperative_groups.h>
#include <cstdio>
#include <cstdint>
namespace cg = cooperative_groups;

#ifndef MK_SINGLE
#define MK_SINGLE 1
#endif

constexpr int DM = 1024, DFF = 4096, NP = 5376  , SBTOK = 65536;
constexpr int C_NAQ = 0, C_NAK = 512, C_NAV = 1024, C_GQ = 1536, C_GK = 1792, C_GV = 2048, C_GG = 2560, C_SNA = 3072, C_SGLA = 4096, C_LR = 5120;
constexpr float RMS_EPS = 1e-6f;
namespace pg8 {
#define PG8_LAS __attribute__((address_space(3)))
typedef unsigned short bf16_t;
typedef short bf16x8 __attribute__((ext_vector_type(8)));
typedef float f32x4 __attribute__((ext_vector_type(4)));
typedef unsigned u32x4 __attribute__((ext_vector_type(4)));
constexpr int BM = 256, BK = 64, HALF = 128, HTB = HALF * BK * 2  , STAGE_BYTES = 8 * HTB, NXCD = 8, WGM = 8;

__host__ __device__ __forceinline__ int lds_byte(int r, int c) { const int st = (r >> 4) * 2 + (c >> 5), rr = r & 15, cc = c & 31, ob = rr * 64 + cc * 2; return st * 1024 + (ob ^ (((ob >> 9) & 1) << 5)); }
__host__ __device__ __forceinline__ void stage_rc(int b, int& R, int& C) { const int st = b / 1024, sb = b % 1024, swz = sb ^ (((sb >> 9) & 1) << 5); R = (st >> 1) * 16 + swz / 64; C = (st & 1) * 32 + (swz % 64) / 2; }
__host__ __device__ __forceinline__ int perm32(int rho) { const int n = rho >> 4, i = rho & 15; return 8 * (i >> 2) + 4 * n + (i & 3); }

struct Unit { int pm, pn; };
struct Gemm { const bf16_t* A; const bf16_t* Bt; int M, N, K; };

struct StaticOrder {
    int nM, nN, nwg, G, c;
    __host__ __device__ void init(int M, int N, int G_, int c_) { nM = M / BM; nN = N / BM; nwg = nM * nN; G = G_; c = c_; }
    __host__ __device__ bool next(int i, Unit& u) const {
        const long L = (long)i * G + c; if (L >= nwg) return false;
        int wgid = (int)L; { const int q = nwg / NXCD, r = nwg % NXCD, xcd = wgid % NXCD, off = wgid / NXCD; wgid = (xcd < r ? xcd * (q + 1) : r * (q + 1) + (xcd - r) * q) + off; }
        const int nig = WGM * nN, gid = wgid / nig, fm = gid * WGM, gsz = (nM - fm) < WGM ? (nM - fm) : WGM;
        u.pm = fm + ((wgid % nig) % gsz); u.pn = (wgid % nig) / gsz; return true;
    }
    __device__ __forceinline__ void a_ready(const Unit&) const {}
    __device__ __forceinline__ void done(const Unit&) const {}
};

__device__ __forceinline__ unsigned cvt_pk_bf16(float lo, float hi) { unsigned r; asm volatile("v_cvt_pk_bf16_f32 %0, %1, %2" : "=v"(r) : "v"(lo), "v"(hi)); return r; }
typedef unsigned u32x2 __attribute__((ext_vector_type(2)));
__device__ __forceinline__ float bf2f(unsigned short b) { return __uint_as_float((unsigned)b << 16); }
__device__ __forceinline__ float sigmoidf_(float x) { return __builtin_amdgcn_rcpf(1.0f + __expf(-x)); }

struct EpiProj {
    static constexpr bool PERM = true, AFTER_DRAIN = false, MID = false;
    bf16_t* O; const float* bias;
    __device__ __forceinline__ void operator()(const f32x4 (&acc)[2][2][4][2], const Unit& u, int wr, int wc, int fr, int fq) const {
        const int row0 = u.pm * BM + wr * 64 + fr, pn = u.pn;
        const int mode = (pn < 2 || pn == 6) ? 1 : ((pn == 10 || pn == 11) ? 2 : ((pn >= 12 && pn < 20) ? 3 : 0));
        const int col0 = pn * BM + wc * 32 + 8 * fq;
        f32x4 bv[2][2];
#pragma unroll
        for (int bj = 0; bj < 2; ++bj)
#pragma unroll
            for (int n = 0; n < 2; ++n) bv[bj][n] = *(const f32x4*)(bias + col0 + bj * HALF + 4 * n);
#pragma unroll
        for (int ai = 0; ai < 2; ++ai)
#pragma unroll
            for (int m = 0; m < 4; ++m) { bf16_t* rowp = O + (size_t)(row0 + ai * HALF + m * 16) * NP + col0;
#pragma unroll
                for (int bj = 0; bj < 2; ++bj) { f32x4 v0 = acc[ai][bj][m][0] + bv[bj][0], v1 = acc[ai][bj][m][1] + bv[bj][1];
                    if (mode == 1) { v0 = v0 * 0.125f; v1 = v1 * 0.125f; }
                    else if (mode == 2) {
#pragma unroll
                        for (int e = 0; e < 4; ++e) { v0[e] = v0[e] * sigmoidf_(v0[e]); v1[e] = v1[e] * sigmoidf_(v1[e]); } }
                    else if (mode == 3) {
#pragma unroll
                        for (int e = 0; e < 4; ++e) { v0[e] = sigmoidf_(v0[e]); v1[e] = sigmoidf_(v1[e]); } }
                    u32x4 w; w.x = cvt_pk_bf16(v0[0], v0[1]); w.y = cvt_pk_bf16(v0[2], v0[3]); w.z = cvt_pk_bf16(v1[0], v1[1]); w.w = cvt_pk_bf16(v1[2], v1[3]);
                    *(u32x4*)(rowp + bj * HALF) = w; } }
    }
};

template <bool ADD> struct EpiBranch {
    static constexpr bool PERM = true, AFTER_DRAIN = false, MID = false;
    const bf16_t* proj; int gcol; bf16_t* O;
    __device__ __forceinline__ void operator()(const f32x4 (&acc)[2][2][4][2], const Unit& u, int wr, int wc, int fr, int fq) const {
        const int row0 = u.pm * BM + wr * 64 + fr, col0 = u.pn * BM + wc * 32 + 8 * fq;
#pragma unroll
        for (int ai = 0; ai < 2; ++ai)
#pragma unroll
            for (int m = 0; m < 4; ++m) { const size_t r = (size_t)(row0 + ai * HALF + m * 16);
#pragma unroll
                for (int bj = 0; bj < 2; ++bj) {
                    const u32x4 gw = *(const u32x4*)(proj + r * NP + gcol + col0 + bj * HALF);
                    u32x4 pw = (u32x4){0u, 0u, 0u, 0u}; if (ADD) pw = *(const u32x4*)(O + r * DM + col0 + bj * HALF);
                    float o[8];
#pragma unroll
                    for (int e = 0; e < 8; ++e) { const unsigned g2 = gw[e >> 1], p2 = pw[e >> 1];
                        const float gt = (e & 1) ? __uint_as_float(g2 & 0xffff0000u) : __uint_as_float(g2 << 16);
                        const float pv = (e & 1) ? __uint_as_float(p2 & 0xffff0000u) : __uint_as_float(p2 << 16);
                        o[e] = pv + gt * acc[ai][bj][m][e >> 2][e & 3]; }
                    u32x4 w; w.x = cvt_pk_bf16(o[0], o[1]); w.y = cvt_pk_bf16(o[2], o[3]); w.z = cvt_pk_bf16(o[4], o[5]); w.w = cvt_pk_bf16(o[6], o[7]);
                    *(u32x4*)(O + r * DM + col0 + bj * HALF) = w; }
                asm volatile("" ::: "memory"); }
    }
};

struct EpiBranchFused {
    static constexpr bool PERM = true, AFTER_DRAIN = false, MID = true;
    const bf16_t* proj; bf16_t* O;
    __device__ __forceinline__ void mid(f32x4 (&acc)[2][2][4][2], const Unit& u, int wr, int wc, int fr_in, int fq_in) const {
        int fr = fr_in, fq = fq_in; asm volatile("" : "+v"(fr), "+v"(fq));
        const int row0 = u.pm * BM + wr * 64 + fr, col0 = u.pn * BM + wc * 32 + 8 * fq;
#pragma unroll
        for (int ai = 0; ai < 2; ++ai)
#pragma unroll
            for (int m = 0; m < 4; ++m) { const size_t r = (size_t)(row0 + ai * HALF + m * 16);
#pragma unroll
                for (int bj = 0; bj < 2; ++bj) {
                    const u32x4 ga = *(const u32x4*)(proj + r * NP + C_SNA + col0 + bj * HALF), gb = *(const u32x4*)(proj + r * NP + C_SGLA + col0 + bj * HALF);
#pragma unroll
                    for (int e = 0; e < 8; ++e) { const unsigned a2 = ga[e >> 1], b2 = gb[e >> 1];
                        const float sa = (e & 1) ? __uint_as_float(a2 & 0xffff0000u) : __uint_as_float(a2 << 16), sb = (e & 1) ? __uint_as_float(b2 & 0xffff0000u) : __uint_as_float(b2 << 16);
                        acc[ai][bj][m][e >> 2][e & 3] *= sa * __builtin_amdgcn_rcpf(sb); } }
                if (m == 3) asm volatile("" ::: "memory"); }
    }
    __device__ __forceinline__ void operator()(const f32x4 (&acc)[2][2][4][2], const Unit& u, int wr, int wc, int fr, int fq) const {
        const int row0 = u.pm * BM + wr * 64 + fr, col0 = u.pn * BM + wc * 32 + 8 * fq;
#pragma unroll
        for (int ai = 0; ai < 2; ++ai)
#pragma unroll
            for (int m = 0; m < 4; ++m) { const size_t r = (size_t)(row0 + ai * HALF + m * 16);
#pragma unroll
                for (int bj = 0; bj < 2; ++bj) {
                    const u32x4 gb = *(const u32x4*)(proj + r * NP + C_SGLA + col0 + bj * HALF);
                    float o[8];
#pragma unroll
                    for (int e = 0; e < 8; ++e) { const unsigned b2 = gb[e >> 1]; const float sb = (e & 1) ? __uint_as_float(b2 & 0xffff0000u) : __uint_as_float(b2 << 16);
                        o[e] = sb * acc[ai][bj][m][e >> 2][e & 3]; }
                    u32x4 w; w.x = cvt_pk_bf16(o[0], o[1]); w.y = cvt_pk_bf16(o[2], o[3]); w.z = cvt_pk_bf16(o[4], o[5]); w.w = cvt_pk_bf16(o[6], o[7]);
                    *(u32x4*)(O + r * DM + col0 + bj * HALF) = w; }
                if (m == 3) asm volatile("" ::: "memory"); }
    }
};

struct EpiOut {
    static constexpr bool PERM = false, AFTER_DRAIN = false, MID = false;
    const float* base; bf16_t* hb; float* ssq;
    __device__ __forceinline__ void operator()(const f32x4 (&acc)[2][2][4][2], const Unit& u, int wr, int wc, int fr, int fq) const {
        const int col0 = u.pn * BM + wc * 32 + 4 * fq;
#pragma unroll
        for (int ai = 0; ai < 2; ++ai) {
            f32x4 xv[4][2][2];
#pragma unroll
            for (int m = 0; m < 4; ++m) { const size_t r = (size_t)(u.pm * BM + ai * HALF + wr * 64 + m * 16 + fr);
#pragma unroll
                for (int bj = 0; bj < 2; ++bj)
#pragma unroll
                    for (int n = 0; n < 2; ++n) xv[m][bj][n] = *(const f32x4*)(base + r * DM + col0 + bj * HALF + n * 16); }
#pragma unroll
            for (int m = 0; m < 4; ++m) { const size_t r = (size_t)(u.pm * BM + ai * HALF + wr * 64 + m * 16 + fr); float s = 0.f;
#pragma unroll
                for (int bj = 0; bj < 2; ++bj)
#pragma unroll
                    for (int n = 0; n < 2; ++n) { const size_t off = r * DM + col0 + bj * HALF + n * 16;
                        const f32x4 h = xv[m][bj][n] + acc[ai][bj][m][n];
                        s += (h[0] * h[0] + h[1] * h[1]) + (h[2] * h[2] + h[3] * h[3]);
                        u32x2 w; w.x = cvt_pk_bf16(h[0], h[1]); w.y = cvt_pk_bf16(h[2], h[3]); *(u32x2*)(hb + off) = w; }
                s += __shfl_xor(s, 16); s += __shfl_xor(s, 32);
                if (fq == 0) atomicAdd(ssq + r, s); }
            asm volatile("" ::: "memory"); }
    }
};
struct EpiDownNorm {
    static constexpr bool PERM = false, AFTER_DRAIN = false, MID = false;
    const bf16_t* hb; float* out; float* ssq; unsigned* cnt; const float* gain;
    __device__ __forceinline__ void operator()(const f32x4 (&acc_)[2][2][4][2], const Unit& u, int wr, int wc, int fr, int fq) const {
        f32x4 (&acc)[2][2][4][2] = const_cast<f32x4 (&)[2][2][4][2]>(acc_);
        const int col0 = u.pn * BM + wc * 32 + 4 * fq;
#pragma unroll
        for (int ai = 0; ai < 2; ++ai) {
            u32x2 hv[4][2][2];
#pragma unroll
            for (int m = 0; m < 4; ++m) { const size_t r = (size_t)(u.pm * BM + ai * HALF + wr * 64 + m * 16 + fr);
#pragma unroll
                for (int bj = 0; bj < 2; ++bj)
#pragma unroll
                    for (int n = 0; n < 2; ++n) hv[m][bj][n] = *(const u32x2*)(hb + r * DM + col0 + bj * HALF + n * 16); }
#pragma unroll
            for (int m = 0; m < 4; ++m) { const size_t r = (size_t)(u.pm * BM + ai * HALF + wr * 64 + m * 16 + fr); float s = 0.f;
#pragma unroll
                for (int bj = 0; bj < 2; ++bj)
#pragma unroll
                    for (int n = 0; n < 2; ++n) { const u32x2 hw = hv[m][bj][n];
                        f32x4 h = acc[ai][bj][m][n];
                        h[0] += __uint_as_float(hw.x << 16); h[1] += __uint_as_float(hw.x & 0xffff0000u); h[2] += __uint_as_float(hw.y << 16); h[3] += __uint_as_float(hw.y & 0xffff0000u);
                        acc[ai][bj][m][n] = h; s += (h[0] * h[0] + h[1] * h[1]) + (h[2] * h[2] + h[3] * h[3]); }
                s += __shfl_xor(s, 16); s += __shfl_xor(s, 32);
                if (fq == 0) atomicAdd(ssq + r, s); }
            asm volatile("" ::: "memory"); }
        asm volatile("s_waitcnt vmcnt(0)" ::: "memory");
        if ((threadIdx.x & 63) == 0) __hip_atomic_fetch_add(cnt + u.pm, 1u, __ATOMIC_RELAXED, __HIP_MEMORY_SCOPE_AGENT);
        {   unsigned spins = 0;
            while ((unsigned)__builtin_amdgcn_readfirstlane((int)__hip_atomic_load(cnt + u.pm, __ATOMIC_RELAXED, __HIP_MEMORY_SCOPE_AGENT)) < 32u) { __builtin_amdgcn_s_sleep(2); if (++spins > (1u << 22)) break; } }
        asm volatile("" ::: "memory");
#pragma unroll
        for (int ai = 0; ai < 2; ++ai)
#pragma unroll
            for (int m = 0; m < 4; ++m) { const size_t r = (size_t)(u.pm * BM + ai * HALF + wr * 64 + m * 16 + fr);
                const float rstd = rsqrtf(__hip_atomic_load(ssq + r, __ATOMIC_RELAXED, __HIP_MEMORY_SCOPE_AGENT) * (1.0f / DM) + RMS_EPS);
#pragma unroll
                for (int bj = 0; bj < 2; ++bj)
#pragma unroll
                    for (int n = 0; n < 2; ++n) { const size_t off = r * DM + col0 + bj * HALF + n * 16; const f32x4 gg = *(const f32x4*)(gain + col0 + bj * HALF + n * 16);
                        *(f32x4*)(out + off) = acc[ai][bj][m][n] * rstd * gg; }
                asm volatile("" ::: "memory"); }
    }
};

struct EpiUp {
    static constexpr bool PERM = true, AFTER_DRAIN = false, MID = false;
    const float* ssq; bf16_t* O;
    __device__ __forceinline__ void operator()(const f32x4 (&acc)[2][2][4][2], const Unit& u, int wr, int wc, int fr, int fq) const {
        const int row0 = u.pm * BM + wr * 64 + fr, col0 = u.pn * BM + wc * 32 + 8 * fq;
#pragma unroll
        for (int ai = 0; ai < 2; ++ai)
#pragma unroll
            for (int m = 0; m < 4; ++m) { const size_t r = (size_t)(row0 + ai * HALF + m * 16);
                const float rstd = rsqrtf(ssq[r] * (1.0f / DM) + RMS_EPS);
#pragma unroll
                for (int bj = 0; bj < 2; ++bj) { f32x4 v0 = acc[ai][bj][m][0] * rstd, v1 = acc[ai][bj][m][1] * rstd;
#pragma unroll
                    for (int e = 0; e < 4; ++e) { const float a = fmaxf(v0[e], 0.f), b = fmaxf(v1[e], 0.f); v0[e] = a * a; v1[e] = b * b; }
                    u32x4 w; w.x = cvt_pk_bf16(v0[0], v0[1]); w.y = cvt_pk_bf16(v0[2], v0[3]); w.z = cvt_pk_bf16(v1[0], v1[1]); w.w = cvt_pk_bf16(v1[2], v1[3]);
                    const int col = col0 + bj * HALF;
                    *(u32x4*)(O + ((((r >> 8) * (DFF / 64) + (col >> 6)) * 256 + (r & 255)) * 64 + (col & 63))) = w; } }
    }
};

template <class Epi, class Sched, bool ALIGN_EPI = false, bool SP2 = false, bool TILED = false>
__device__ __forceinline__ void gemm_phase(PG8_LAS unsigned char* lds, const Gemm g, const Sched& S, const Epi& E) {
    int tid_ = threadIdx.x; asm volatile("" : "+v"(tid_));
    const int tid = tid_, wid = __builtin_amdgcn_readfirstlane(tid >> 6), lane = tid & 63, wr = wid >> 2, wc = wid & 3, fr = lane & 15, fq = lane >> 4;
    const int K = g.K, nt = K / BK;
    unsigned voffA[2], voffB[2];
#pragma unroll
    for (int i = 0; i < 2; ++i) { int R, C; stage_rc(tid * 16 + i * 8192, R, C); const int Rb = Epi::PERM ? ((R & ~31) + perm32(R & 31)) : R;
        const int rs = TILED ? BK : K; voffA[i] = (unsigned)(R * rs + C) * 2u; voffB[i] = (unsigned)(Rb * rs + C) * 2u; }
    const size_t kstep = TILED ? (size_t)(BM * BK * 2) : (size_t)(BK * 2);
    const size_t hstep = TILED ? (size_t)(HALF * BK * 2) : (size_t)HALF * K * 2;
    const size_t tstep = TILED ? (size_t)(K / BK) * (BM * BK * 2) : 2 * hstep;
    const unsigned ldsw = (unsigned)wid * 1024u;
    const int aoff = lds_byte(wr * 64 + fr, fq * 8), boff = lds_byte(wc * 32 + fr, fq * 8);
#define PG8_SA(b, h) (((b) * 2 + (h)) * HTB)
#define PG8_SB(b, h) ((4 + (b) * 2 + (h)) * HTB)
#define PG8_STAGE(bufoff, gbase, voff) do { _Pragma("unroll") for (int _i = 0; _i < 2; ++_i) \
        __builtin_amdgcn_global_load_lds((const unsigned*)((const char*)(gbase) + (voff)[_i]), (PG8_LAS unsigned*)(lds + (bufoff) + ldsw + _i * 8192), 16, 0, 0); } while (0)
#define PG8_LDA(dst, b, h) do { _Pragma("unroll") for (int m = 0; m < 4; ++m) _Pragma("unroll") for (int k = 0; k < 2; ++k) dst[m][k] = *(const PG8_LAS bf16x8*)(lds + PG8_SA(b, h) + aoff + m * 2048 + k * 1024); } while (0)
#define PG8_LDB(dst, b, h) do { _Pragma("unroll") for (int n = 0; n < 2; ++n) _Pragma("unroll") for (int k = 0; k < 2; ++k) dst[n][k] = *(const PG8_LAS bf16x8*)(lds + PG8_SB(b, h) + boff + n * 2048 + k * 1024); } while (0)
#define PG8_MMA(ai, bj, At, Bt) do { __builtin_amdgcn_s_setprio(1); _Pragma("unroll") for (int m = 0; m < 4; ++m) _Pragma("unroll") for (int n = 0; n < 2; ++n) _Pragma("unroll") for (int k = 0; k < 2; ++k) \
        acc[ai][bj][m][n] = __builtin_amdgcn_mfma_f32_16x16x32_bf16(Bt[n][k], At[m][k], acc[ai][bj][m][n], 0, 0, 0); __builtin_amdgcn_s_setprio(0); } while (0)
#define PG8_WAIT_V(n) asm volatile("s_waitcnt vmcnt(" #n ")" ::: "memory")
#define PG8_WAIT_L(n) asm volatile("s_waitcnt lgkmcnt(" #n ")" ::: "memory")
#define PG8_BAR __builtin_amdgcn_s_barrier()
#define PG8_SCHED __builtin_amdgcn_sched_barrier(0)
    Unit cur, nxt; int ui = 0;
    if (!S.next(0, cur)) return;
    f32x4 acc[2][2][4][2];
#pragma unroll
    for (int a = 0; a < 2; ++a)
#pragma unroll
        for (int b = 0; b < 2; ++b)
#pragma unroll
            for (int m = 0; m < 4; ++m)
#pragma unroll
                for (int n = 0; n < 2; ++n) acc[a][b][m][n] = (f32x4){0.f, 0.f, 0.f, 0.f};
    bf16x8 At[4][2], B0[2][2], B1[2][2];
    const char* cA = (const char*)g.A + (size_t)cur.pm * tstep; const char* cB = (const char*)g.Bt + (size_t)cur.pn * tstep;
    S.a_ready(cur);
    if constexpr (SP2) {
        PG8_STAGE(PG8_SB(0, 0), cB, voffB); PG8_STAGE(PG8_SB(0, 1), cB + hstep, voffB); PG8_STAGE(PG8_SA(0, 0), cA, voffA); PG8_STAGE(PG8_SA(0, 1), cA + hstep, voffA);
        if (wr == 1) PG8_BAR;
        PG8_WAIT_V(2); PG8_BAR;
        PG8_STAGE(PG8_SB(1, 0), cB + kstep, voffB); PG8_STAGE(PG8_SA(1, 0), cA + kstep, voffA); PG8_STAGE(PG8_SB(1, 1), cB + hstep + kstep, voffB);
        PG8_WAIT_V(6); PG8_BAR;
    } else {
        PG8_STAGE(PG8_SB(0, 0), cB, voffB); PG8_STAGE(PG8_SA(0, 0), cA, voffA); PG8_STAGE(PG8_SB(0, 1), cB + hstep, voffB); PG8_STAGE(PG8_SA(0, 1), cA + hstep, voffA);
        if (wr == 1) PG8_BAR;
        PG8_WAIT_V(4); PG8_BAR;
        PG8_STAGE(PG8_SB(1, 0), cB + kstep, voffB); PG8_STAGE(PG8_SA(1, 0), cA + kstep, voffA); PG8_STAGE(PG8_SB(1, 1), cB + hstep + kstep, voffB);
        PG8_WAIT_V(6); PG8_BAR;
    }
    for (;;) {
        const bool has_next = S.next(ui + 1, nxt);
        const char* nA = has_next ? (const char*)g.A + (size_t)nxt.pm * tstep : cA; const char* nB = has_next ? (const char*)g.Bt + (size_t)nxt.pn * tstep : cB;
        for (int t = 0; t < nt; t += 2) {
            const bool last = (t == nt - 2);
            const char* a1 = cA + (size_t)(t + 1) * kstep;
            const char* a2 = last ? nA : cA + (size_t)(t + 2) * kstep; const char* b2 = last ? nB : cB + (size_t)(t + 2) * kstep;
            const char* a3 = a2 + kstep; const char* b3 = b2 + kstep;
            if (last && has_next) S.a_ready(nxt);
            if constexpr (Epi::MID) { if (t == nt / 2) E.mid(acc, cur, wr, wc, fr, fq); }
            if constexpr (SP2) {
            PG8_LDB(B0, 0, 0); PG8_LDB(B1, 0, 1); PG8_SCHED; PG8_LDA(At, 0, 0); PG8_STAGE(PG8_SA(1, 1), a1 + hstep, voffA);
            PG8_WAIT_V(8); PG8_WAIT_L(0); PG8_BAR; PG8_MMA(0, 0, At, B0); PG8_MMA(0, 1, At, B1); PG8_BAR; PG8_SCHED;
            PG8_LDA(At, 0, 1); PG8_STAGE(PG8_SB(0, 0), b2, voffB); PG8_STAGE(PG8_SB(0, 1), b2 + hstep, voffB); PG8_STAGE(PG8_SA(0, 0), a2, voffA);
            PG8_WAIT_V(8); PG8_WAIT_L(0); PG8_BAR; PG8_MMA(1, 0, At, B0); PG8_MMA(1, 1, At, B1); PG8_BAR; PG8_SCHED;
            PG8_LDB(B0, 1, 0); PG8_LDB(B1, 1, 1); PG8_SCHED; PG8_LDA(At, 1, 0); PG8_STAGE(PG8_SA(0, 1), a2 + hstep, voffA);
            PG8_WAIT_V(8); PG8_WAIT_L(0); PG8_BAR; PG8_MMA(0, 0, At, B0); PG8_MMA(0, 1, At, B1); PG8_BAR; PG8_SCHED;
            PG8_LDA(At, 1, 1); PG8_STAGE(PG8_SB(1, 0), b3, voffB); PG8_STAGE(PG8_SB(1, 1), b3 + hstep, voffB); PG8_STAGE(PG8_SA(1, 0), a3, voffA);
            PG8_WAIT_V(8); PG8_WAIT_L(0); PG8_BAR; PG8_MMA(1, 0, At, B0); PG8_MMA(1, 1, At, B1); PG8_BAR; PG8_SCHED;
            } else {
            PG8_LDB(B0, 0, 0); PG8_SCHED; PG8_LDA(At, 0, 0); PG8_STAGE(PG8_SA(1, 1), a1 + hstep, voffA);
            PG8_WAIT_L(8); PG8_BAR; PG8_WAIT_L(0); PG8_MMA(0, 0, At, B0); PG8_BAR; PG8_SCHED;
            PG8_LDB(B1, 0, 1); PG8_STAGE(PG8_SB(0, 0), b2, voffB);
            PG8_BAR; PG8_WAIT_L(0); PG8_MMA(0, 1, At, B1); PG8_BAR;
            PG8_LDA(At, 0, 1); PG8_STAGE(PG8_SA(0, 0), a2, voffA);
            PG8_BAR; PG8_WAIT_L(0); PG8_MMA(1, 0, At, B0); PG8_BAR; PG8_SCHED;
            PG8_STAGE(PG8_SB(0, 1), b2 + hstep, voffB);
            PG8_WAIT_V(6); PG8_BAR; PG8_MMA(1, 1, At, B1); PG8_BAR;
            PG8_LDB(B0, 1, 0); PG8_SCHED; PG8_LDA(At, 1, 0); PG8_STAGE(PG8_SA(0, 1), a2 + hstep, voffA);
            PG8_WAIT_L(8); PG8_BAR; PG8_WAIT_L(0); PG8_MMA(0, 0, At, B0); PG8_BAR; PG8_SCHED;
            PG8_LDB(B1, 1, 1); PG8_STAGE(PG8_SB(1, 0), b3, voffB);
            PG8_BAR; PG8_WAIT_L(0); PG8_MMA(0, 1, At, B1); PG8_BAR;
            PG8_LDA(At, 1, 1); PG8_STAGE(PG8_SA(1, 0), a3, voffA);
            PG8_BAR; PG8_WAIT_L(0); PG8_MMA(1, 0, At, B0); PG8_BAR; PG8_SCHED;
            PG8_STAGE(PG8_SB(1, 1), b3 + hstep, voffB);
            PG8_WAIT_V(6); PG8_BAR; PG8_MMA(1, 1, At, B1); PG8_BAR;
            }
        }
        if constexpr (ALIGN_EPI) { if (wr == 0) PG8_BAR; }
        if constexpr (!Epi::AFTER_DRAIN) { E(acc, cur, wr, wc, fr, fq); S.done(cur); }
        if (!has_next) break;
#pragma unroll
        for (int a = 0; a < 2; ++a)
#pragma unroll
            for (int b = 0; b < 2; ++b)
#pragma unroll
                for (int m = 0; m < 4; ++m)
#pragma unroll
                    for (int n = 0; n < 2; ++n) acc[a][b][m][n] = (f32x4){0.f, 0.f, 0.f, 0.f};
        cur = nxt; cA = nA; cB = nB; ++ui;
        if constexpr (ALIGN_EPI) { if (wr == 1) PG8_BAR; }
    }
    PG8_WAIT_V(0);
    if constexpr (!ALIGN_EPI) { if (wr == 0) PG8_BAR; }
    PG8_BAR;
    if constexpr (Epi::AFTER_DRAIN) { E.fused(acc, cur, wr, wc, fr, fq, lds, wid, lane); S.done(cur); }
#undef PG8_SA
#undef PG8_SB
#undef PG8_STAGE
#undef PG8_LDA
#undef PG8_LDB
#undef PG8_MMA
#undef PG8_WAIT_V
#undef PG8_WAIT_L
#undef PG8_BAR
#undef PG8_SCHED
}
}

#define LAS __attribute__((address_space(3)))
#define DI __device__ __forceinline__
typedef unsigned short bf16;
typedef short bf16x8 __attribute__((ext_vector_type(8)));
typedef short s16x4 __attribute__((ext_vector_type(4)));
typedef float f32x4 __attribute__((ext_vector_type(4)));
typedef float f32x2 __attribute__((ext_vector_type(2)));
typedef unsigned u32x4 __attribute__((ext_vector_type(4)));
typedef unsigned u32x2 __attribute__((ext_vector_type(2)));
typedef __bf16 bf16v2 __attribute__((ext_vector_type(2)));
constexpr int NWAVES = 8, NTHR = 512;
constexpr int LDS_BYTES = 155648;

constexpr size_t MiB = 1u << 20;
constexpr size_t WS_CTL = 0, CTL_BYTES = 2 * MiB;
constexpr size_t WS_SSQ1 = 512 * 1024, WS_SSQ2 = 1024 * 1024;
constexpr size_t WS_WIN = 2 * MiB, WS_WNA = 13 * MiB, WS_WGLA = 14 * MiB, WS_WOUT = 15 * MiB, WS_WUP = 17 * MiB, WS_WDOWN = 25 * MiB, WS_BIAS = 33 * MiB;
constexpr size_t WS_U = 34 * MiB;
constexpr size_t WS_NAO = 162 * MiB, WS_GLAO = 226 * MiB;
constexpr size_t WS_PROJ = 290 * MiB;
constexpr size_t WS_END = 962 * MiB;

DI float bf2f(unsigned short b) { return __uint_as_float((unsigned)b << 16); }
DI unsigned pk2(float lo, float hi) { f32x2 v = {lo, hi}; bf16v2 b = __builtin_convertvector(v, bf16v2); return __builtin_bit_cast(unsigned, b); }
DI unsigned short f2bf(float x) { return (unsigned short)(pk2(x, 0.f) & 0xffffu); }
DI float wave_sum(float v) {
#pragma unroll
    for (int o = 1; o < 64; o <<= 1) v += __shfl_xor(v, o);
    return v;
}
#define LDS_WAIT() asm volatile("s_waitcnt lgkmcnt(0)" ::: "memory")
#define BAR_LDS() do { asm volatile("s_waitcnt lgkmcnt(0)" ::: "memory"); __builtin_amdgcn_s_barrier(); asm volatile("" ::: "memory"); } while (0)
#define MFMA32(a, b, c) __builtin_amdgcn_mfma_f32_16x16x32_bf16((a), (b), (c), 0, 0, 0)
#define MFMA16(a, b, c) __builtin_amdgcn_mfma_f32_16x16x16bf16_1k((a), (b), (c), 0, 0, 0)

struct Args {
    const float* x[2]; const float* norm_mix_g; const float* w_in; const float* b_in; const float* na_rpb;
    const float* gk_w[2]; const float* gk_b[2]; const float* gla_norm_g; const float* w_br_na; const float* w_br_gla; const float* w_out;
    const float* norm_mlp_g; const float* w_up; const float* w_down; const float* norm_final_g;
    float* out; unsigned char* ws; int ph_lo, ph_hi, coop, pad;
};

template <int MODE>
DI void transpose_item(const float* W, int K, int N, bf16* WT, LAS float* scr, int item, int lane, const float* g, int ldk = 0, int koff = 0) {
    if (ldk == 0) ldk = K;
    const int nblk = N / 32, kb = item / nblk, nb = item % nblk, k0 = 64 * kb, n0 = 32 * nb;
#pragma unroll 8
    for (int i = 0; i < 32; ++i) { const int kk = 2 * i + (lane >> 5); float v = W[(size_t)(k0 + kk) * N + n0 + (lane & 31)]; if (MODE == 2) v *= g[k0 + kk]; scr[kk * 33 + (lane & 31)] = v; }
    LDS_WAIT();
    int d0 = n0; if (MODE == 1) d0 = (n0 < 3072) ? n0 : ((n0 < 3104) ? (C_LR + (n0 - 3072)) : (n0 - 32));
    const int c = lane & 7;
#pragma unroll
    for (int j = 0; j < 4; ++j) { const int n = (lane >> 3) + 8 * j; const LAS float* s = scr + (8 * c) * 33 + n;
        u32x4 o; o.x = pk2(s[0 * 33], s[1 * 33]); o.y = pk2(s[2 * 33], s[3 * 33]); o.z = pk2(s[4 * 33], s[5 * 33]); o.w = pk2(s[6 * 33], s[7 * 33]);
        if (MODE == 3) *(u32x4*)(WT + ((((size_t)((d0 + n) >> 8) * (K / 64) + (k0 >> 6)) * 256 + ((d0 + n) & 255)) * 64 + 8 * c)) = o;
        else *(u32x4*)(WT + (size_t)(d0 + n) * ldk + koff + k0 + 8 * c) = o; }
    LDS_WAIT();
}
DI void rms_row2_to_bf16(const float* xrow0, const float* xrow1, const float* g, bf16* orow0, bf16* orow1, int lane) {
    const f32x4* xr0 = (const f32x4*)xrow0 + lane; const f32x4* xr1 = (const f32x4*)xrow1 + lane; const f32x4* gr = (const f32x4*)g + lane;
    f32x4 v0[4], v1[4]; float s0 = 0.f, s1 = 0.f;
#pragma unroll
    for (int j = 0; j < 4; ++j) { v0[j] = __builtin_nontemporal_load(xr0 + 64 * j); v1[j] = __builtin_nontemporal_load(xr1 + 64 * j); }
#pragma unroll
    for (int j = 0; j < 4; ++j) { s0 += (v0[j].x * v0[j].x + v0[j].y * v0[j].y) + (v0[j].z * v0[j].z + v0[j].w * v0[j].w); s1 += (v1[j].x * v1[j].x + v1[j].y * v1[j].y) + (v1[j].z * v1[j].z + v1[j].w * v1[j].w); }
    const float r0 = rsqrtf(wave_sum(s0) * (1.f / DM) + RMS_EPS), r1 = rsqrtf(wave_sum(s1) * (1.f / DM) + RMS_EPS);
    u32x2* o0 = (u32x2*)orow0 + lane; u32x2* o1 = (u32x2*)orow1 + lane;
#pragma unroll
    for (int j = 0; j < 4; ++j) { const f32x4 gg = gr[64 * j]; u32x2 w;
        w.x = pk2(v0[j].x * r0 * gg.x, v0[j].y * r0 * gg.y); w.y = pk2(v0[j].z * r0 * gg.z, v0[j].w * r0 * gg.w); o0[64 * j] = w;
        w.x = pk2(v1[j].x * r1 * gg.x, v1[j].y * r1 * gg.y); w.y = pk2(v1[j].z * r1 * gg.z, v1[j].w * r1 * gg.w); o1[64 * j] = w; }
}
DI void rms_row_to_bf16(const float* xrow, const float* g, bf16* orow, int lane) {
    const f32x4* xr = (const f32x4*)xrow + lane; const f32x4* gr = (const f32x4*)g + lane;
    f32x4 v[4]; float s = 0.f;
#pragma unroll
    for (int j = 0; j < 4; ++j) { v[j] = xr[64 * j]; s += (v[j].x * v[j].x + v[j].y * v[j].y) + (v[j].z * v[j].z + v[j].w * v[j].w); }
    const float rstd = rsqrtf(wave_sum(s) * (1.f / DM) + RMS_EPS);
    u32x2* o8 = (u32x2*)orow + lane;
#pragma unroll
    for (int j = 0; j < 4; ++j) { const f32x4 gg = gr[64 * j]; u32x2 w; w.x = pk2(v[j].x * rstd * gg.x, v[j].y * rstd * gg.y); w.y = pk2(v[j].z * rstd * gg.z, v[j].w * rstd * gg.w); o8[64 * j] = w; }
}
DI void final_row(float* row, const float* g, float ssq, int lane) {
    f32x4* xr = (f32x4*)row + lane; const f32x4* gr = (const f32x4*)g + lane;
    const float rstd = rsqrtf(ssq * (1.f / DM) + RMS_EPS);
#pragma unroll
    for (int j = 0; j < 4; ++j) { f32x4 v = xr[64 * j]; const f32x4 gg = gr[64 * j]; v = v * rstd; v = v * gg; xr[64 * j] = v; }
}

constexpr int GL_P = 144;
constexpr int GL_QD = 0, GL_KI = 9216, GL_KDT = 18432, GL_VT = 27648, GL_DEC = 46080, GL_LR = 47104, GL_CL = 51200, GL_OB = 52224, GL_OBP = 272, GL_DIR = 52224 + 64 * 272;
constexpr int GSEG = 1024;
DI float logsigmoid_(float x) { return fminf(x, 0.f) - __logf(1.0f + __expf(-fabsf(x))); }

DI void gla_pass1(LAS unsigned char* lds, const Args& A, const bf16* proj, bf16* scratch, bf16* QS, bf16* HT, float* DD, int T, int b, int h, int k, int tid_in) {
    int tid = tid_in; asm volatile("" : "+v"(tid));
    const int lane = tid & 63, wave = tid >> 6, dir = wave >> 2, c = wave & 3, d = lane, g = lane >> 4, l15 = lane & 15;
    LAS unsigned char* L = lds + dir * GL_DIR;
    constexpr int NI = GSEG / 64;
    const size_t rowb = (size_t)b * T + (size_t)k * GSEG;
    const int sidx = ((b * 4 + h) * (T / GSEG) + k) * 2 + dir;
    unsigned gkp[8];
#pragma unroll
    for (int j = 0; j < 8; ++j) gkp[j] = pk2(A.gk_w[dir][(2 * j) * 256 + h * 64 + d], A.gk_w[dir][(2 * j + 1) * 256 + h * 64 + d]);
    const float gkb = A.gk_b[dir][h * 64 + d];
    f32x4 S[4][2];
#pragma unroll
    for (int mt = 0; mt < 4; ++mt)
#pragma unroll
        for (int nt = 0; nt < 2; ++nt) S[mt][nt] = (f32x4){0.f, 0.f, 0.f, 0.f};
    const int vs = c * 32;
    const int tl = tid & 255;
    float carry = 0.f;
    unsigned short qraw[16], kraw[16]; u32x2 lrraw; u32x4 vraw[4];
#define GLA_ROW(s) (rowb + (size_t)(dir ? (GSEG - 1 - (s)) : (s)))
#define GLA_PREFETCH(it) do { const int s0_ = (it) * 64; \
        _Pragma("unroll") for (int i = 0; i < 16; ++i) { const bf16* p_ = proj + GLA_ROW(s0_ + c * 16 + i) * NP + h * 64 + d; qraw[i] = p_[C_GQ]; kraw[i] = p_[C_GK]; } \
        lrraw = *(const u32x2*)(proj + GLA_ROW(s0_ + c * 16 + (lane >> 2)) * NP + C_LR + dir * 16 + (lane & 3) * 4); \
        _Pragma("unroll") for (int q = 0; q < 4; ++q) { const int idx_ = tl + 256 * q; vraw[q] = *(const u32x4*)(proj + GLA_ROW(s0_ + (idx_ & 63)) * NP + C_GV + h * 128 + (idx_ >> 6) * 8); } } while (0)
#define GLA_FLUSH(itf) do { _Pragma("unroll") for (int q_ = 0; q_ < 4; ++q_) { const int idx_ = tl + 256 * q_, tk_ = idx_ >> 4, ch_ = idx_ & 15; \
        *(u32x4*)(scratch + GLA_ROW((itf) * 64 + tk_) * DM + dir * 512 + h * 128 + ch_ * 8) = *(const LAS u32x4*)(L + GL_OB + tk_ * GL_OBP + ch_ * 16); } } while (0)
    GLA_PREFETCH(0);
#pragma unroll 1
    for (int it = 0; it < NI; ++it) {
        BAR_LDS();
        if (it > 0) GLA_FLUSH(it - 1);
        *(LAS u32x2*)(L + GL_LR + (c * 16 + (lane >> 2)) * 32 + (lane & 3) * 8) = lrraw;
        LDS_WAIT();
        float qdv[16];
        {   float cum = 0.f; float kinv[16];
#pragma unroll
            for (int i = 0; i < 16; ++i) {
                const LAS u32x4* lr4 = (const LAS u32x4*)(L + GL_LR + (c * 16 + i) * 32);
                const u32x4 la_ = lr4[0], lb_ = lr4[1];
                const unsigned lw[8] = {la_.x, la_.y, la_.z, la_.w, lb_.x, lb_.y, lb_.z, lb_.w};
                float pre = gkb;
#pragma unroll
                for (int j = 0; j < 8; ++j) pre = __builtin_amdgcn_fdot2_f32_bf16(__builtin_bit_cast(bf16v2, lw[j]), __builtin_bit_cast(bf16v2, gkp[j]), pre, false);
                cum += logsigmoid_(pre) * (1.0f / 16.0f);
                const float e = __expf(cum); qdv[i] = bf2f(qraw[i]) * e;
                kinv[i] = bf2f(kraw[i]) * __builtin_amdgcn_rcpf(e);
                *(LAS unsigned short*)(L + GL_QD + (c * 16 + i) * GL_P + d * 2) = f2bf(qdv[i]);
                *(LAS unsigned short*)(L + GL_KI + (c * 16 + i) * GL_P + d * 2) = f2bf(kinv[i]);
            }
            const float eL = __expf(cum);
            ((LAS float*)(L + GL_DEC))[c * 64 + d] = eL;
            ((LAS float*)(L + GL_CL))[c * 64 + d] = cum;
            u32x4 w0, w1;
            w0.x = pk2(kinv[0] * eL, kinv[1] * eL); w0.y = pk2(kinv[2] * eL, kinv[3] * eL); w0.z = pk2(kinv[4] * eL, kinv[5] * eL); w0.w = pk2(kinv[6] * eL, kinv[7] * eL);
            w1.x = pk2(kinv[8] * eL, kinv[9] * eL); w1.y = pk2(kinv[10] * eL, kinv[11] * eL); w1.z = pk2(kinv[12] * eL, kinv[13] * eL); w1.w = pk2(kinv[14] * eL, kinv[15] * eL);
            *(LAS u32x4*)(L + GL_KDT + d * GL_P + c * 32) = w0; *(LAS u32x4*)(L + GL_KDT + d * GL_P + c * 32 + 16) = w1;
        }
#pragma unroll
        for (int q = 0; q < 4; ++q) { const int idx = tl + 256 * q, tk = idx & 63, v0 = (idx >> 6) * 8;
#pragma unroll
            for (int e = 0; e < 8; ++e) { const unsigned w = vraw[q][e >> 1]; *(LAS unsigned short*)(L + GL_VT + (v0 + e) * GL_P + tk * 2) = (unsigned short)((e & 1) ? (w >> 16) : (w & 0xffffu)); } }
        BAR_LDS();
        {   const LAS float* CL = (const LAS float*)(L + GL_CL) + d; const float c0 = CL[0], c1 = CL[64], c2 = CL[128], c3 = CL[192];
            const float off = carry + ((c > 0) ? c0 : 0.f) + ((c > 1) ? c1 : 0.f) + ((c > 2) ? c2 : 0.f);
            carry += (c0 + c1) + (c2 + c3);
            const float eo = __expf(off);
#pragma unroll
            for (int i = 0; i < 16; ++i) QS[GLA_ROW(it * 64 + c * 16 + i) * 512 + dir * 256 + h * 64 + d] = f2bf(qdv[i] * eo); }
#pragma unroll
        for (int cc = 0; cc < 4; ++cc) {
            const int trow = cc * 16 + l15;
            f32x4 X = (f32x4){0.f, 0.f, 0.f, 0.f};
#pragma unroll
            for (int ks = 0; ks < 2; ++ks) { const bf16x8 ki = *(const LAS bf16x8*)(L + GL_KI + trow * GL_P + (ks * 32 + 8 * g) * 2), qd = *(const LAS bf16x8*)(L + GL_QD + trow * GL_P + (ks * 32 + 8 * g) * 2);
                X = MFMA32(ki, qd, X); }
#pragma unroll
            for (int r = 0; r < 4; ++r) if (4 * g + r > l15) X[r] = 0.f;
            u32x2 pp; pp.x = pk2(X[0], X[1]); pp.y = pk2(X[2], X[3]);
            const s16x4 P = __builtin_bit_cast(s16x4, pp);
            s16x4 vt[2]; f32x4 o[2];
#pragma unroll
            for (int nt = 0; nt < 2; ++nt) { vt[nt] = *(const LAS s16x4*)(L + GL_VT + (vs + 16 * nt + l15) * GL_P + (cc * 16 + 4 * g) * 2);
                o[nt] = MFMA16(P, vt[nt], ((f32x4){0.f, 0.f, 0.f, 0.f})); }
#pragma unroll
            for (int ks = 0; ks < 2; ++ks) {
                const u32x2 qlo = *(const LAS u32x2*)(L + GL_QD + trow * GL_P + (32 * ks + 4 * g) * 2), qhi = *(const LAS u32x2*)(L + GL_QD + trow * GL_P + (32 * ks + 16 + 4 * g) * 2);
                const u32x4 qq = (u32x4){qlo.x, qlo.y, qhi.x, qhi.y}; const bf16x8 qa = __builtin_bit_cast(bf16x8, qq);
#pragma unroll
                for (int nt = 0; nt < 2; ++nt) { const f32x4 s0 = S[2 * ks][nt], s1 = S[2 * ks + 1][nt];
                    const u32x4 sw = (u32x4){pk2(s0[0], s0[1]), pk2(s0[2], s0[3]), pk2(s1[0], s1[1]), pk2(s1[2], s1[3])};
                    o[nt] = MFMA32(qa, __builtin_bit_cast(bf16x8, sw), o[nt]); } }
#pragma unroll
            for (int r = 0; r < 4; ++r) { LAS unsigned short* op = (LAS unsigned short*)(L + GL_OB + (cc * 16 + 4 * g + r) * GL_OBP + (vs + l15) * 2); op[0] = f2bf(o[0][r]); op[16] = f2bf(o[1][r]); }
#pragma unroll
            for (int mt = 0; mt < 4; ++mt) { const f32x4 dec = *(const LAS f32x4*)(L + GL_DEC + (cc * 64 + 16 * mt + 4 * g) * 4);
                const s16x4 kd = *(const LAS s16x4*)(L + GL_KDT + (16 * mt + l15) * GL_P + (cc * 16 + 4 * g) * 2);
#pragma unroll
                for (int nt = 0; nt < 2; ++nt) { f32x4 sv = S[mt][nt]; sv = sv * dec; S[mt][nt] = MFMA16(kd, vt[nt], sv); } }
            if (cc == 1 && it + 1 < NI) GLA_PREFETCH(it + 1);
        }
    }
    BAR_LDS();
    GLA_FLUSH(NI - 1);
#undef GLA_FLUSH
#undef GLA_PREFETCH
#undef GLA_ROW
#pragma unroll
    for (int mt = 0; mt < 4; ++mt)
#pragma unroll
        for (int nt = 0; nt < 2; ++nt) { u32x2 w; w.x = pk2(S[mt][nt][0], S[mt][nt][1]); w.y = pk2(S[mt][nt][2], S[mt][nt][3]);
            *(u32x2*)(HT + ((size_t)sidx * 128 + vs + 16 * nt + l15) * 64 + 16 * mt + 4 * g) = w; }
    if (c == 0) DD[(size_t)sidx * 64 + d] = __expf(carry);
    __syncthreads();
}

constexpr int G2_S0 = 0, G2_OT = 36864, G2_OTP = 132;
DI void gla_pass2(LAS unsigned char* lds, const Args& A, const bf16* proj, const bf16* scratch, const bf16* QS, const bf16* HT, const float* DD, bf16* glao, int T, int b, int h, int k, int tid_in) {
    int tid = tid_in; asm volatile("" : "+v"(tid));
    const int lane = tid & 63, wave = tid >> 6, g = lane >> 4, l15 = lane & 15;
    const int nseg = T / GSEG;
    const size_t rowb = (size_t)b * T + (size_t)k * GSEG;
    const int ntk = tid >> 3, nvc = tid & 7;
    bf16x8 AF[4][2][2]; u32x4 SC[2][2]; u32x4 gw[2];
#define G2_LOAD(grp) do { _Pragma("unroll") for (int mt_ = 0; mt_ < 4; ++mt_) { const size_t r0_ = rowb + (grp) * 64 + mt_ * 16; \
        _Pragma("unroll") for (int dir_ = 0; dir_ < 2; ++dir_) _Pragma("unroll") for (int ks_ = 0; ks_ < 2; ++ks_) AF[mt_][dir_][ks_] = *(const bf16x8*)(QS + (r0_ + l15) * 512 + dir_ * 256 + h * 64 + ks_ * 32 + 8 * g); \
        } \
        { const u32x4* gp_ = (const u32x4*)(proj + (rowb + (grp) * 64 + ntk) * NP + C_GG + h * 128 + nvc * 16); gw[0] = gp_[0]; gw[1] = gp_[1]; \
          const u32x4* sp_ = (const u32x4*)(scratch + (rowb + (grp) * 64 + ntk) * DM + h * 128 + nvc * 16); SC[0][0] = sp_[0]; SC[0][1] = sp_[1]; SC[1][0] = sp_[64]; SC[1][1] = sp_[65]; } } while (0)
    G2_LOAD(0);
    {   const int dir = tid >> 8, oct = tid & 7, vq = (tid & 255) >> 3;
        float acc[4][8], w[8];
#pragma unroll
        for (int e = 0; e < 8; ++e) { w[e] = 1.f;
#pragma unroll
            for (int j = 0; j < 4; ++j) acc[j][e] = 0.f; }
        const int nsteps = dir ? (nseg - 1 - k) : k;
        const int sbase = ((b * 4 + h) * nseg) * 2 + dir, mstep = dir ? 2 : -2;
        int si = sbase + 2 * (dir ? (k + 1) : (k - 1));
        u32x4 hc[4]; f32x4 dc[2];
#define G2_LDH(sidx, hh, dd) do { _Pragma("unroll") for (int j_ = 0; j_ < 4; ++j_) hh[j_] = *(const u32x4*)(HT + ((size_t)(sidx) * 128 + vq + 32 * j_) * 64 + oct * 8); \
        dd[0] = *(const f32x4*)(DD + (size_t)(sidx) * 64 + oct * 8); dd[1] = *(const f32x4*)(DD + (size_t)(sidx) * 64 + oct * 8 + 4); } while (0)
        if (nsteps > 0) G2_LDH(si, hc, dc);
#pragma unroll 1
        for (int st = 0; st < nsteps; ++st) {
            u32x4 hn[4]; f32x4 dn[2];
#pragma unroll
            for (int j = 0; j < 4; ++j) hn[j] = hc[j];
            dn[0] = dc[0]; dn[1] = dc[1];
            si += mstep;
            if (st + 1 < nsteps) G2_LDH(si, hn, dn);
#pragma unroll
            for (int j = 0; j < 4; ++j)
#pragma unroll
                for (int e = 0; e < 8; ++e) { const unsigned x = hc[j][e >> 1]; const float hv = (e & 1) ? __uint_as_float(x & 0xffff0000u) : __uint_as_float(x << 16); acc[j][e] += w[e] * hv; }
#pragma unroll
            for (int e = 0; e < 8; ++e) w[e] *= (e < 4) ? dc[0][e & 3] : dc[1][e & 3];
#pragma unroll
            for (int j = 0; j < 4; ++j) hc[j] = hn[j];
            dc[0] = dn[0]; dc[1] = dn[1];
        }
#undef G2_LDH
#pragma unroll
        for (int j = 0; j < 4; ++j) *(LAS u32x4*)(lds + G2_S0 + dir * 18432 + (vq + 32 * j) * GL_P + oct * 16) =
            (u32x4){pk2(acc[j][0], acc[j][1]), pk2(acc[j][2], acc[j][3]), pk2(acc[j][4], acc[j][5]), pk2(acc[j][6], acc[j][7])};
    }
    BAR_LDS();
    bf16x8 Bf[2][2];
#pragma unroll
    for (int dir = 0; dir < 2; ++dir)
#pragma unroll
        for (int ks = 0; ks < 2; ++ks) Bf[dir][ks] = *(const LAS bf16x8*)(lds + G2_S0 + dir * 18432 + (16 * wave + l15) * GL_P + (ks * 32 + 8 * g) * 2);
    LAS float* OT = (LAS float*)(lds + G2_OT);
    f32x4 gn[4];
#pragma unroll
    for (int j = 0; j < 4; ++j) gn[j] = *(const f32x4*)(A.gla_norm_g + nvc * 16 + 4 * j);
#pragma unroll 1
    for (int grp = 0; grp < GSEG / 64; ++grp) {
#pragma unroll
        for (int mtile = 0; mtile < 4; ++mtile) {
            f32x4 acc = (f32x4){0.f, 0.f, 0.f, 0.f};
#pragma unroll
            for (int dir = 0; dir < 2; ++dir)
#pragma unroll
                for (int ks = 0; ks < 2; ++ks) acc = MFMA32(AF[mtile][dir][ks], Bf[dir][ks], acc);
#pragma unroll
            for (int r = 0; r < 4; ++r) OT[(mtile * 16 + 4 * g + r) * G2_OTP + 16 * wave + l15] = acc[r];
        }
        const u32x4 gw0 = gw[0], gw1 = gw[1], sf0 = SC[0][0], sf1 = SC[0][1], sb0 = SC[1][0], sb1 = SC[1][1];
        if (grp + 1 < GSEG / 64) G2_LOAD(grp + 1);
        BAR_LDS();
        {   const size_t row = rowb + grp * 64 + ntk; f32x4 sv[4]; float ss = 0.f;
#pragma unroll
            for (int j = 0; j < 4; ++j) { const u32x4 cf = (j < 2) ? sf0 : sf1, cb = (j < 2) ? sb0 : sb1; const unsigned f0 = cf[2 * (j & 1)], f1 = cf[2 * (j & 1) + 1], b0 = cb[2 * (j & 1)], b1 = cb[2 * (j & 1) + 1];
                f32x4 lo; lo.x = __uint_as_float(f0 << 16) + __uint_as_float(b0 << 16); lo.y = __uint_as_float(f0 & 0xffff0000u) + __uint_as_float(b0 & 0xffff0000u);
                lo.z = __uint_as_float(f1 << 16) + __uint_as_float(b1 << 16); lo.w = __uint_as_float(f1 & 0xffff0000u) + __uint_as_float(b1 & 0xffff0000u);
                sv[j] = *(const LAS f32x4*)(OT + ntk * G2_OTP + nvc * 16 + 4 * j) + lo; ss += (sv[j].x * sv[j].x + sv[j].y * sv[j].y) + (sv[j].z * sv[j].z + sv[j].w * sv[j].w); }
            ss += __shfl_xor(ss, 1); ss += __shfl_xor(ss, 2); ss += __shfl_xor(ss, 4);
            const float rstd = rsqrtf(ss * (1.0f / 128.0f) + RMS_EPS);
            u32x4* op = (u32x4*)(glao + row * DM + h * 128 + nvc * 16);
#pragma unroll
            for (int j2 = 0; j2 < 2; ++j2) { const u32x4 gq = j2 ? gw1 : gw0; const f32x4 a = sv[2 * j2] * rstd * gn[2 * j2], bb = sv[2 * j2 + 1] * rstd * gn[2 * j2 + 1];
                u32x4 w;
                w.x = pk2(a.x * __uint_as_float(gq.x << 16), a.y * __uint_as_float(gq.x & 0xffff0000u)); w.y = pk2(a.z * __uint_as_float(gq.y << 16), a.w * __uint_as_float(gq.y & 0xffff0000u));
                w.z = pk2(bb.x * __uint_as_float(gq.z << 16), bb.y * __uint_as_float(gq.z & 0xffff0000u)); w.w = pk2(bb.z * __uint_as_float(gq.w << 16), bb.w * __uint_as_float(gq.w & 0xffff0000u));
                op[j2] = w; }
        }
        BAR_LDS();
    }
#undef G2_LOAD
}

constexpr int NA_K = 0, NA_V = 65536, NA_MRG = 131072, NA_BIAS = 131072 + 18432, NA_ITEM = NA_BIAS + 1920;
static_assert(NA_ITEM + 64 <= LDS_BYTES, "NA LDS map");
DI void na_phase(LAS unsigned char* lds, const Args& A, const bf16* proj, bf16* nao, int T, int nB, unsigned* counter, int tid_in) {
    int tid = tid_in; asm volatile("" : "+v"(tid));
    const int lane = tid & 63, wave = tid >> 6, qg = wave & 3, kh = wave >> 2, g = lane >> 4, l15 = lane & 15;
    constexpr int NAR = 32;
    const int rows = T / 64, nr = rows / NAR, nitems = nB * 8 * nr;
    const int cq = 16 * qg + l15;
    const int cs0 = (qg == 0) ? 0 : ((qg == 1) ? 8 : ((qg == 2) ? 24 : 32));
    const int csq = min(max(cq - 8, 0), 48);
    const int lc = tid >> 3, lc8 = tid & 7;
    for (int item = (int)blockIdx.x; item < nitems; item += (int)gridDim.x) {
        __syncthreads();
        const int b = item / (8 * nr), h = (item / nr) & 7, r0 = (item % nr) * NAR;
        const size_t rowb = (size_t)b * T;
        if (tid < 465) ((LAS float*)(lds + NA_BIAS))[tid] = A.na_rpb[h * 465 + tid];
#define NA_RS(r) min(max((r) - 4, 0), rows - 8)
#define NA_LOADROW(kr, kreg, vreg) do { const bf16* p_ = proj + (rowb + (size_t)(kr) * 64 + lc) * NP + h * 64 + lc8 * 8; kreg = *(const u32x4*)(p_ + C_NAK); vreg = *(const u32x4*)(p_ + C_NAV); } while (0)
#define NA_STOREROW(kr, kreg, vreg) do { const int sl_ = (kr) & 7; \
            *(LAS u32x4*)(lds + NA_K + sl_ * 8192 + lc * 128 + ((lc8 ^ ((lc >> 1) & 7)) * 16)) = kreg; \
            _Pragma("unroll") for (int e = 0; e < 8; ++e) { const int d_ = lc8 * 8 + e; const unsigned w_ = vreg[e >> 1]; \
                *(LAS unsigned short*)(lds + NA_V + sl_ * 8192 + d_ * 128 + (((lc >> 2) ^ (2 * ((d_ >> 1) & 7))) * 8) + (lc & 3) * 2) = (unsigned short)((e & 1) ? (w_ >> 16) : (w_ & 0xffffu)); } } while (0)
        {   const int rs0 = NA_RS(r0); u32x4 kr8[8], vr8[8];
#pragma unroll
            for (int i = 0; i < 8; ++i) NA_LOADROW(rs0 + i, kr8[i], vr8[i]);
#pragma unroll
            for (int i = 0; i < 8; ++i) NA_STOREROW(rs0 + i, kr8[i], vr8[i]); }
        bf16x8 qf[2], qn[2];
#define NA_LOADQ(r, dst) do { const bf16* p_ = proj + (rowb + (size_t)(r) * 64 + cq) * NP + C_NAQ + h * 64 + 8 * g; dst[0] = *(const bf16x8*)p_; dst[1] = *(const bf16x8*)(p_ + 32); } while (0)
        NA_LOADQ(r0, qf);
        __syncthreads();
#pragma unroll 1
        for (int r = r0; r < r0 + NAR; ++r) {
            const int rs = NA_RS(r);
            const bool more = (r + 1 < r0 + NAR), need_new = more && (NA_RS(r + 1) != rs);
            u32x4 kreg = (u32x4){0u, 0u, 0u, 0u}, vreg = (u32x4){0u, 0u, 0u, 0u};
            if (need_new) NA_LOADROW(rs + 8, kreg, vreg);
            if (more) NA_LOADQ(r + 1, qn);
            f32x4 sT[4][2]; float mx = -INFINITY;
            const LAS float* BI = (const LAS float*)(lds + NA_BIAS);
#pragma unroll
            for (int rr = 0; rr < 4; ++rr) { const int kr = rs + 4 * kh + rr, sl = kr & 7;
#pragma unroll
                for (int ct = 0; ct < 2; ++ct) { const int cm = cs0 + 16 * ct + l15; f32x4 acc = (f32x4){0.f, 0.f, 0.f, 0.f};
#pragma unroll
                    for (int ks = 0; ks < 2; ++ks) { const bf16x8 kf = *(const LAS bf16x8*)(lds + NA_K + sl * 8192 + cm * 128 + (((4 * ks + g) ^ ((cm >> 1) & 7)) * 16)); acc = MFMA32(kf, qf[ks], acc); }
#pragma unroll
                    for (int e = 0; e < 4; ++e) { const int cc = cs0 + 16 * ct + 4 * g + e; const bool valid = (cc >= csq) && (cc < csq + 16);
                        const int bi = (kr - r + 7) * 31 + min(max(cc - cq + 15, 0), 30);
                        const float sv = valid ? acc[e] + BI[bi] : -INFINITY; acc[e] = sv; mx = fmaxf(mx, sv); }
                    sT[rr][ct] = acc; } }
            mx = fmaxf(mx, __shfl_xor(mx, 16)); mx = fmaxf(mx, __shfl_xor(mx, 32));
            float lsum = 0.f;
#pragma unroll
            for (int rr = 0; rr < 4; ++rr)
#pragma unroll
                for (int ct = 0; ct < 2; ++ct)
#pragma unroll
                    for (int e = 0; e < 4; ++e) { const float p = __expf(sT[rr][ct][e] - mx); sT[rr][ct][e] = p; lsum += p; }
            lsum += __shfl_xor(lsum, 16); lsum += __shfl_xor(lsum, 32);
            f32x4 O[4];
#pragma unroll
            for (int mt = 0; mt < 4; ++mt) O[mt] = (f32x4){0.f, 0.f, 0.f, 0.f};
#pragma unroll
            for (int rr = 0; rr < 4; ++rr) { const int sl = (rs + 4 * kh + rr) & 7;
                const u32x4 pw = (u32x4){pk2(sT[rr][0][0], sT[rr][0][1]), pk2(sT[rr][0][2], sT[rr][0][3]), pk2(sT[rr][1][0], sT[rr][1][1]), pk2(sT[rr][1][2], sT[rr][1][3])};
                const bf16x8 pb = __builtin_bit_cast(bf16x8, pw);
#pragma unroll
                for (int mt = 0; mt < 4; ++mt) { const int dd = 16 * mt + l15, sw = 2 * ((dd >> 1) & 7);
                    const LAS unsigned char* vb = lds + NA_V + sl * 8192 + dd * 128;
                    const u32x2 lo = *(const LAS u32x2*)(vb + ((((cs0 >> 2) + g) ^ sw) * 8)), hi = *(const LAS u32x2*)(vb + ((((cs0 >> 2) + 4 + g) ^ sw) * 8));
                    const u32x4 vv = (u32x4){lo.x, lo.y, hi.x, hi.y};
                    O[mt] = MFMA32(__builtin_bit_cast(bf16x8, vv), pb, O[mt]); } }
            LAS float* MG = (LAS float*)(lds + NA_MRG + qg * 4608) + lane;
            if (kh == 1) { MG[0] = mx; MG[64] = lsum;
#pragma unroll
                for (int mt = 0; mt < 4; ++mt)
#pragma unroll
                    for (int e = 0; e < 4; ++e) MG[(2 + mt * 4 + e) * 64] = O[mt][e]; }
            __syncthreads();
            if (kh == 0) { const float m1 = MG[0], l1 = MG[64], M = fmaxf(mx, m1), a0 = __expf(mx - M), a1 = __expf(m1 - M), inv = 1.0f / (lsum * a0 + l1 * a1);
                bf16* op = nao + (rowb + (size_t)r * 64 + cq) * DM + h * 64 + 4 * g;
#pragma unroll
                for (int mt = 0; mt < 4; ++mt) { float v[4];
#pragma unroll
                    for (int e = 0; e < 4; ++e) v[e] = (O[mt][e] * a0 + MG[(2 + mt * 4 + e) * 64] * a1) * inv;
                    u32x2 w; w.x = pk2(v[0], v[1]); w.y = pk2(v[2], v[3]); *(u32x2*)(op + 16 * mt) = w; } }
            if (need_new) NA_STOREROW(rs + 8, kreg, vreg);
            if (more) { qf[0] = qn[0]; qf[1] = qn[1]; }
            __syncthreads();
        }
#undef NA_RS
#undef NA_LOADROW
#undef NA_STOREROW
#undef NA_LOADQ
    }
    __syncthreads();
}

#define XB_TMO      128
#define XB_XCNT(j)  (256  + 64 * (j))
#define XB_XSUB(j)  (1280 + 64 * (j))
#define XB_XGEN(j)  (2304 + 64 * (j))
#define XB_TOP      3328
#define XB_TOPGEN   3392
#define XCD_BAR_WORDS 3456
#define XB_SPIN_CAP (1u << 18)

__device__ __forceinline__ unsigned xb_ld(unsigned* p)              { return __hip_atomic_load(p, __ATOMIC_RELAXED, __HIP_MEMORY_SCOPE_AGENT); }
__device__ __forceinline__ unsigned xb_add(unsigned* p, unsigned v) { return __hip_atomic_fetch_add(p, v, __ATOMIC_RELAXED, __HIP_MEMORY_SCOPE_AGENT); }
__device__ __forceinline__ unsigned xb_xcc_id() { return (unsigned)__builtin_amdgcn_s_getreg((3 << 11) | 20) & 0xFu; }
#define XB_SPIN(cond, bar) do { unsigned _sp = 0; while (cond) { __builtin_amdgcn_s_sleep(1); \
    if ((++_sp & 255u) == 0u) { if (xb_ld(&(bar)[XB_TMO])) break; if (_sp > XB_SPIN_CAP) { atomicAdd(&(bar)[XB_TMO], 1u); break; } } } } while (0)

struct XcdBarrier {
    unsigned* bar; unsigned x;
    volatile LAS unsigned* st;
};

__device__ __forceinline__ XcdBarrier xcd_barrier_post(unsigned* bar, volatile LAS unsigned* st) {
    XcdBarrier b; b.bar = bar; b.x = xb_xcc_id(); b.st = st;
    if (threadIdx.x == 0) (void)xb_add(&bar[XB_XCNT(b.x)], 1u);
    return b;
}
__device__ __forceinline__ void xcd_barrier_complete(unsigned* bar, unsigned x, unsigned& nloc, unsigned& nx) {
    const unsigned G = gridDim.x * gridDim.y * gridDim.z;
    unsigned sum, cnt, mine, sp = 0u;
    for (;;) {
        sum = 0u; cnt = 0u; mine = 0u;
#pragma unroll
        for (unsigned j = 0; j < 16; ++j) { const unsigned c = xb_ld(&bar[XB_XCNT(j)]); sum += c; cnt += (c > 0u) ? 1u : 0u; mine = (j == x) ? c : mine; }
        if (sum == G) break;
        __builtin_amdgcn_s_sleep(1);
        if ((++sp & 255u) == 0u) { if (xb_ld(&bar[XB_TMO])) break; if (sp > XB_SPIN_CAP) { atomicAdd(&bar[XB_TMO], 1u); break; } }
    }
    nloc = mine > 0u ? mine : 1u; nx = cnt > 0u ? cnt : 1u;
}

__device__ __forceinline__ void xcd_barrier(const XcdBarrier& b) {
    asm volatile("s_waitcnt vmcnt(0)" ::: "memory");
    __syncthreads();
    if (threadIdx.x == 0) {
        unsigned* bar = b.bar;
        __builtin_amdgcn_s_waitcnt(0);
        unsigned nloc = b.st[0], nx = b.st[1];
        if (nloc == 0u) { xcd_barrier_complete(bar, b.x, nloc, nx); b.st[0] = nloc; b.st[1] = nx; }
        const unsigned old = xb_add(&bar[XB_XSUB(b.x)], 1u);
        const unsigned gen = old / nloc;
        if (old + 1u == (gen + 1u) * nloc) {
            __builtin_amdgcn_fence(__ATOMIC_RELEASE, "agent");
            asm volatile("s_waitcnt vmcnt(0)" ::: "memory");
            const unsigned og = xb_add(&bar[XB_TOP], 1u);
            const unsigned tg = og / nx;
            if (og + 1u == (tg + 1u) * nx) xb_add(&bar[XB_TOPGEN], 1u);
            else XB_SPIN(xb_ld(&bar[XB_TOPGEN]) == tg, bar);
            __builtin_amdgcn_fence(__ATOMIC_ACQUIRE, "agent");
            xb_add(&bar[XB_XGEN(b.x)], 1u);
            asm volatile("s_waitcnt vmcnt(0)" ::: "memory");
        } else {
            XB_SPIN(xb_ld(&bar[XB_XGEN(b.x)]) == gen, bar);
            __builtin_amdgcn_fence(__ATOMIC_ACQUIRE, "agent");
            asm volatile("s_waitcnt vmcnt(0)" ::: "memory");
        }
    }
    __syncthreads();
}

constexpr int N_PHASES = 15;
__global__ void __launch_bounds__(NTHR, 2) fwd_kernel(Args A) {
    extern __shared__ __attribute__((aligned(16))) unsigned char lds_raw[];
    LAS unsigned char* lds = (LAS unsigned char*)lds_raw;
    const int tid = threadIdx.x, lane = tid & 63, wave = __builtin_amdgcn_readfirstlane(tid >> 6);
    const int G = gridDim.x, bx = blockIdx.x;
    unsigned char* ws = A.ws;
#define Wt_in ((bf16*)(ws + WS_WIN))
#define Wt_na ((bf16*)(ws + WS_WNA))
#define Wt_gla ((bf16*)(ws + WS_WGLA))
#define Wt_out ((bf16*)(ws + WS_WOUT))
#define Wt_up ((bf16*)(ws + WS_WUP))
#define Wt_down ((bf16*)(ws + WS_WDOWN))
#define biasp ((float*)(ws + WS_BIAS))
#define U ((bf16*)(ws + WS_U))
#define NAO ((bf16*)(ws + WS_NAO))
#define GLAO ((bf16*)(ws + WS_NAO) + 512)
#define HB ((bf16*)(ws + WS_NAO))
#define PROJ ((bf16*)(ws + WS_PROJ))
#define HDN ((bf16*)(ws + WS_PROJ))
#define ctl ((unsigned*)(ws + WS_CTL))
    const int gw = bx * NWAVES + wave, NGW = G * NWAVES;
    const int lo = A.ph_lo, hi = A.ph_hi;
#ifndef PH_MASK
#define PH_MASK 0x1ff
#endif
#define PHM(b) ((PH_MASK >> (b)) & 1)
#define IN(k) (lo <= (k) && (k) < hi)
    if (tid < 2) ((volatile LAS unsigned*)(lds + LDS_BYTES - 64))[tid] = 0u;
    __syncthreads();
    XcdBarrier xbar; xbar.bar = ctl + 4096; xbar.x = 0; xbar.st = nullptr;
    if (A.coop) xbar = xcd_barrier_post(ctl + 4096, (volatile LAS unsigned*)(lds + LDS_BYTES - 64));
#define SEAM(k) do { if (IN(k) && IN((k) + 1)) { if ((k) == 0) cg::this_grid().sync(); else xcd_barrier(xbar); } } while (0)

    if (PHM(0) && IN(0)) {
        LAS float* scr = (LAS float*)(lds + wave * 16384);
        constexpr int I_IN = (DM / 64) * (5152 / 32), I_BR = (512 / 64) * (DM / 32), I_OUT = (DM / 64) * (DM / 32), I_UP = (DM / 64) * (DFF / 32), I_DN = (DFF / 64) * (DM / 32);
        constexpr int NITEMS = I_IN + 2 * I_BR + I_OUT + I_UP + I_DN;
        for (int pass = 0; pass < 2; ++pass) {
        if ((pass ^ (wave & 1)) == 0) {
        for (int it = gw; it < NITEMS; it += NGW) {
            int r = it;
            if (r < I_IN) { transpose_item<1>(A.w_in, DM, 5152, Wt_in, scr, r, lane, nullptr); continue; } r -= I_IN;
            if (r < I_BR) { transpose_item<0>(A.w_br_na, 512, DM, Wt_na, scr, r, lane, nullptr, DM, 0); continue; } r -= I_BR;
            if (r < I_BR) { transpose_item<0>(A.w_br_gla, 512, DM, Wt_na, scr, r, lane, nullptr, DM, 512); continue; } r -= I_BR;
            if (r < I_OUT) { transpose_item<0>(A.w_out, DM, DM, Wt_out, scr, r, lane, nullptr); continue; } r -= I_OUT;
            if (r < I_UP) { transpose_item<2>(A.w_up, DM, DFF, Wt_up, scr, r, lane, A.norm_mlp_g); continue; } r -= I_UP;
            transpose_item<3>(A.w_down, DFF, DM, Wt_down, scr, r, lane, nullptr);
        }
        } else {
        for (int m = gw; m < SBTOK; m += NGW) rms_row2_to_bf16(A.x[0] + (size_t)m * DM, A.x[1] + (size_t)m * DM, A.norm_mix_g, U + (size_t)m * DM, (bf16*)(A.out + (size_t)SBTOK * DM) + (size_t)m * DM, lane);
        }
        }
        {   const int gt = bx * NTHR + tid, NGT = G * NTHR;
            u32x4* zp = (u32x4*)(Wt_in + (size_t)5152 * DM);
            for (int i = gt; i < 224 * DM * 2 / 16; i += NGT) zp[i] = (u32x4){0u, 0u, 0u, 0u};
            for (int n = gt; n < NP; n += NGT) { float v = 0.f; if (n < 3072) v = A.b_in[n]; else if (n < C_LR) v = A.b_in[n + 32]; else if (n < C_LR + 32) v = A.b_in[3072 + (n - C_LR)]; biasp[n] = v; } }
        __syncthreads();
    }
    SEAM(0);

#pragma unroll 1
    for (int sb = 0; sb < 2; ++sb) {
        const int P = 1 + 7 * sb;
        const int T = sb ? 4096 : 2048, nB = sb ? 16 : 32;
        const float* xsb = A.x[sb]; float* outsb = A.out + (size_t)sb * SBTOK * DM;
        float* ssq1 = (float*)(ws + WS_SSQ1) + sb * SBTOK; float* ssq2 = (float*)(ws + WS_SSQ2) + sb * SBTOK;
        if (PHM(1) && IN(P)) { pg8::Gemm g{sb ? (const bf16*)outsb : (const bf16*)U, Wt_in, SBTOK, NP, DM}; pg8::StaticOrder S; S.init(SBTOK, NP, G, bx);
            pg8::EpiProj E{PROJ, biasp};
            pg8::gemm_phase<pg8::EpiProj, pg8::StaticOrder, true, true>(lds, g, S, E); }
        SEAM(P);
        bf16* QS = (bf16*)(ws + WS_U); bf16* HT = (bf16*)(ws + WS_U + 64 * MiB); float* DD = (float*)(ws + WS_U + 96 * MiB);
        const int nseg = T / GSEG, ngla = nB * 4 * nseg;
        if (IN(P + 1)) {
            const bool na_first = ((bx >> 3) & 1) != 0;
            if (PHM(3) && na_first) na_phase(lds, A, PROJ, NAO, T, nB, ctl + 64 * (1 + sb), tid);
            if (PHM(2)) for (int item = bx; item < ngla; item += G) gla_pass1(lds, A, PROJ, (bf16*)outsb, QS, HT, DD, T, item / (4 * nseg), (item / nseg) & 3, item % nseg, tid);
            if (PHM(3) && !na_first) na_phase(lds, A, PROJ, NAO, T, nB, ctl + 64 * (1 + sb), tid);
        }
        SEAM(P + 1);
        if (IN(P + 2)) {
            if (PHM(2)) for (int item = bx; item < ngla; item += G) gla_pass2(lds, A, PROJ, (const bf16*)outsb, QS, HT, DD, GLAO, T, item / (4 * nseg), (item / nseg) & 3, item % nseg, tid);
        }
        SEAM(P + 2);
        if (PHM(4) && IN(P + 3)) { pg8::Gemm g{NAO, Wt_na, SBTOK, DM, DM}; pg8::StaticOrder S; S.init(SBTOK, DM, G, bx); pg8::EpiBranchFused E{PROJ, U};
            pg8::gemm_phase<pg8::EpiBranchFused, pg8::StaticOrder, true, true>(lds, g, S, E); }
        SEAM(P + 3);
        if (PHM(5) && IN(P + 4)) { pg8::Gemm g{U, Wt_out, SBTOK, DM, DM}; pg8::StaticOrder S; S.init(SBTOK, DM, G, bx);
            pg8::EpiOut E{xsb, HB, ssq1};
            pg8::gemm_phase<pg8::EpiOut, pg8::StaticOrder, true, true>(lds, g, S, E); }
        SEAM(P + 4);
        if (PHM(6) && IN(P + 5)) { pg8::Gemm g{HB, Wt_up, SBTOK, DFF, DM}; pg8::StaticOrder S; S.init(SBTOK, DFF, G, bx);
            pg8::EpiUp E{ssq1, HDN};
            pg8::gemm_phase<pg8::EpiUp, pg8::StaticOrder, true, true>(lds, g, S, E); }
        SEAM(P + 5);
        if (PHM(7) && IN(P + 6)) { pg8::Gemm g{HDN, Wt_down, SBTOK, DM, DFF}; pg8::StaticOrder S; S.init(SBTOK, DM, G, bx);
            pg8::EpiDownNorm E{HB, outsb, ssq2, ctl + 1024 + sb * 256, A.norm_final_g};
            pg8::gemm_phase<pg8::EpiDownNorm, pg8::StaticOrder, true, true, true>(lds, g, S, E); }
        if (sb == 0) SEAM(P + 6);
    }
#undef IN
#undef SEAM
}

extern "C" void kernel_launch(void* const* d_in, const int* in_sizes, int n_in, void* d_out, int out_size, void* d_ws, size_t ws_size, hipStream_t stream) {
    static int grid = 0;
    if (grid == 0) {
        if (n_in != 18 || ws_size < WS_END) { fprintf(stderr, "kernel_launch: unexpected n_in %d / ws_size %zu\n", n_in, ws_size); grid = -1; return; }
        int dev = 0, cus = 0, per_cu = 0;
        hipGetDevice(&dev); hipDeviceGetAttribute(&cus, hipDeviceAttributeMultiprocessorCount, dev);
        if (hipFuncSetAttribute((const void*)fwd_kernel, hipFuncAttributeMaxDynamicSharedMemorySize, LDS_BYTES) != hipSuccess) { fprintf(stderr, "kernel_launch: hipFuncSetAttribute failed\n"); grid = -1; return; }
        if (hipOccupancyMaxActiveBlocksPerMultiprocessor(&per_cu, (const void*)fwd_kernel, NTHR, LDS_BYTES) != hipSuccess || per_cu < 1) { fprintf(stderr, "kernel_launch: occupancy query says %d\n", per_cu); per_cu = 1; }
        (void)hipGetLastError();
        grid = cus * per_cu;
    }
    if (grid < 0) return;
    hipMemsetAsync((char*)d_ws + WS_CTL, 0, CTL_BYTES, stream);
    Args a{};
    a.x[0] = (const float*)d_in[0]; a.x[1] = (const float*)d_in[1]; a.norm_mix_g = (const float*)d_in[2]; a.w_in = (const float*)d_in[3]; a.b_in = (const float*)d_in[4];
    a.na_rpb = (const float*)d_in[5]; a.gk_w[0] = (const float*)d_in[6]; a.gk_b[0] = (const float*)d_in[7]; a.gk_w[1] = (const float*)d_in[8]; a.gk_b[1] = (const float*)d_in[9];
    a.gla_norm_g = (const float*)d_in[10]; a.w_br_na = (const float*)d_in[11]; a.w_br_gla = (const float*)d_in[12]; a.w_out = (const float*)d_in[13];
    a.norm_mlp_g = (const float*)d_in[14]; a.w_up = (const float*)d_in[15]; a.w_down = (const float*)d_in[16]; a.norm_final_g = (const float*)d_in[17];
    a.out = (float*)d_out; a.ws = (unsigned char*)d_ws;
#if MK_SINGLE
    a.ph_lo = 0; a.ph_hi = N_PHASES; a.coop = 1;
    void* args[] = {&a};
    hipError_t e = hipLaunchCooperativeKernel((const void*)fwd_kernel, dim3(grid), dim3(NTHR), args, LDS_BYTES, stream);
    if (e != hipSuccess) fprintf(stderr, "cooperative launch failed: %s (grid %d)\n", hipGetErrorString(e), grid);
#else
    for (int p = 0; p < N_PHASES; ++p) { a.ph_lo = p; a.ph_hi = p + 1; a.coop = 0;
        hipLaunchKernelGGL(fwd_kernel, dim3(grid), dim3(NTHR), LDS_BYTES, stream, a); }
#endif
}
```

```cpp
#include <hip/hip_runtime.h>
#include <hip/hip_cooperative_groups.h>
#include <cstdio>
#include <cstdint>
namespace cg = cooperative_groups;

#ifndef MK_SINGLE
#define MK_SINGLE 1
#endif

constexpr int DM = 1024, DFF = 4096, NP = 5376  , SBTOK = 65536;
constexpr int C_NAQ = 0, C_NAK = 512, C_NAV = 1024, C_GQ = 1536, C_GK = 1792, C_GV = 2048, C_GG = 2560, C_SNA = 3072, C_SGLA = 4096, C_LR = 5120;
constexpr float RMS_EPS = 1e-6f;
namespace pg8 {
#define PG8_LAS __attribute__((address_space(3)))
typedef unsigned short bf16_t;
typedef short bf16x8 __attribute__((ext_vector_type(8)));
typedef float f32x4 __attribute__((ext_vector_type(4)));
typedef unsigned u32x4 __attribute__((ext_vector_type(4)));
constexpr int BM = 256, BK = 64, HALF = 128, HTB = HALF * BK * 2  , STAGE_BYTES = 8 * HTB, NXCD = 8, WGM = 8;

__host__ __device__ __forceinline__ int lds_byte(int r, int c) { const int st = (r >> 4) * 2 + (c >> 5), rr = r & 15, cc = c & 31, ob = rr * 64 + cc * 2; return st * 1024 + (ob ^ (((ob >> 9) & 1) << 5)); }
__host__ __device__ __forceinline__ void stage_rc(int b, int& R, int& C) { const int st = b / 1024, sb = b % 1024, swz = sb ^ (((sb >> 9) & 1) << 5); R = (st >> 1) * 16 + swz / 64; C = (st & 1) * 32 + (swz % 64) / 2; }
__host__ __device__ __forceinline__ int perm32(int rho) { const int n = rho >> 4, i = rho & 15; return 8 * (i >> 2) + 4 * n + (i & 3); }

struct Unit { int pm, pn; };
struct Gemm { const bf16_t* A; const bf16_t* Bt; int M, N, K; };

struct StaticOrder {
    int nM, nN, nwg, G, c;
    __host__ __device__ void init(int M, int N, int G_, int c_) { nM = M / BM; nN = N / BM; nwg = nM * nN; G = G_; c = c_; }
    __host__ __device__ bool next(int i, Unit& u) const {
        const long L = (long)i * G + c; if (L >= nwg) return false;
        int wgid = (int)L; { const int q = nwg / NXCD, r = nwg % NXCD, xcd = wgid % NXCD, off = wgid / NXCD; wgid = (xcd < r ? xcd * (q + 1) : r * (q + 1) + (xcd - r) * q) + off; }
        const int nig = WGM * nN, gid = wgid / nig, fm = gid * WGM, gsz = (nM - fm) < WGM ? (nM - fm) : WGM;
        u.pm = fm + ((wgid % nig) % gsz); u.pn = (wgid % nig) / gsz; return true;
    }
    __device__ __forceinline__ void a_ready(const Unit&) const {}
    __device__ __forceinline__ void done(const Unit&) const {}
};

__device__ __forceinline__ unsigned cvt_pk_bf16(float lo, float hi) { unsigned r; asm volatile("v_cvt_pk_bf16_f32 %0, %1, %2" : "=v"(r) : "v"(lo), "v"(hi)); return r; }
typedef unsigned u32x2 __attribute__((ext_vector_type(2)));
__device__ __forceinline__ float bf2f(unsigned short b) { return __uint_as_float((unsigned)b << 16); }
__device__ __forceinline__ float sigmoidf_(float x) { return __builtin_amdgcn_rcpf(1.0f + __builtin_amdgcn_exp2f(-1.4426950408889634f * x)); }

struct EpiProj {
    static constexpr bool PERM = true, AFTER_DRAIN = false, MID = false;
    bf16_t* O; const float* bias;
    __device__ __forceinline__ void operator()(const f32x4 (&acc)[2][2][4][2], const Unit& u, int wr, int wc, int fr, int fq) const {
        const int row0 = u.pm * BM + wr * 64 + fr, pn = u.pn;
        const int mode = (pn < 2 || pn == 6) ? 1 : ((pn == 10 || pn == 11) ? 2 : ((pn >= 12 && pn < 20) ? 3 : 0));
        const int col0 = pn * BM + wc * 32 + 8 * fq;
        f32x4 bv[2][2];
#pragma unroll
        for (int bj = 0; bj < 2; ++bj)
#pragma unroll
            for (int n = 0; n < 2; ++n) bv[bj][n] = *(const f32x4*)(bias + col0 + bj * HALF + 4 * n);
#pragma unroll
        for (int ai = 0; ai < 2; ++ai)
#pragma unroll
            for (int m = 0; m < 4; ++m) { bf16_t* rowp = O + (size_t)(row0 + ai * HALF + m * 16) * NP + col0;
#pragma unroll
                for (int bj = 0; bj < 2; ++bj) { f32x4 v0 = acc[ai][bj][m][0] + bv[bj][0], v1 = acc[ai][bj][m][1] + bv[bj][1];
                    if (mode == 1) { v0 = v0 * 0.125f; v1 = v1 * 0.125f; }
                    else if (mode == 2) {
#pragma unroll
                        for (int e = 0; e < 4; ++e) { v0[e] = v0[e] * sigmoidf_(v0[e]); v1[e] = v1[e] * sigmoidf_(v1[e]); } }
                    else if (mode == 3) {
#pragma unroll
                        for (int e = 0; e < 4; ++e) { v0[e] = sigmoidf_(v0[e]); v1[e] = sigmoidf_(v1[e]); } }
                    u32x4 w; w.x = cvt_pk_bf16(v0[0], v0[1]); w.y = cvt_pk_bf16(v0[2], v0[3]); w.z = cvt_pk_bf16(v1[0], v1[1]); w.w = cvt_pk_bf16(v1[2], v1[3]);
                    *(u32x4*)(rowp + bj * HALF) = w; } }
    }
};

template <bool ADD> struct EpiBranch {
    static constexpr bool PERM = true, AFTER_DRAIN = false, MID = false;
    const bf16_t* proj; int gcol; bf16_t* O;
    __device__ __forceinline__ void operator()(const f32x4 (&acc)[2][2][4][2], const Unit& u, int wr, int wc, int fr, int fq) const {
        const int row0 = u.pm * BM + wr * 64 + fr, col0 = u.pn * BM + wc * 32 + 8 * fq;
#pragma unroll
        for (int ai = 0; ai < 2; ++ai)
#pragma unroll
            for (int m = 0; m < 4; ++m) { const size_t r = (size_t)(row0 + ai * HALF + m * 16);
#pragma unroll
                for (int bj = 0; bj < 2; ++bj) {
                    const u32x4 gw = *(const u32x4*)(proj + r * NP + gcol + col0 + bj * HALF);
                    u32x4 pw = (u32x4){0u, 0u, 0u, 0u}; if (ADD) pw = *(const u32x4*)(O + r * DM + col0 + bj * HALF);
                    float o[8];
#pragma unroll
                    for (int e = 0; e < 8; ++e) { const unsigned g2 = gw[e >> 1], p2 = pw[e >> 1];
                        const float gt = (e & 1) ? __uint_as_float(g2 & 0xffff0000u) : __uint_as_float(g2 << 16);
                        const float pv = (e & 1) ? __uint_as_float(p2 & 0xffff0000u) : __uint_as_float(p2 << 16);
                        o[e] = pv + gt * acc[ai][bj][m][e >> 2][e & 3]; }
                    u32x4 w; w.x = cvt_pk_bf16(o[0], o[1]); w.y = cvt_pk_bf16(o[2], o[3]); w.z = cvt_pk_bf16(o[4], o[5]); w.w = cvt_pk_bf16(o[6], o[7]);
                    *(u32x4*)(O + r * DM + col0 + bj * HALF) = w; }
                asm volatile("" ::: "memory"); }
    }
};

struct EpiBranchFused {
    static constexpr bool PERM = true, AFTER_DRAIN = false, MID = true;
    const bf16_t* proj; bf16_t* O;
    __device__ __forceinline__ void mid(f32x4 (&acc)[2][2][4][2], const Unit& u, int wr, int wc, int fr_in, int fq_in) const {
        int fr = fr_in, fq = fq_in; asm volatile("" : "+v"(fr), "+v"(fq));
        const int row0 = u.pm * BM + wr * 64 + fr, col0 = u.pn * BM + wc * 32 + 8 * fq;
#pragma unroll
        for (int ai = 0; ai < 2; ++ai)
#pragma unroll
            for (int m = 0; m < 4; ++m) { const size_t r = (size_t)(row0 + ai * HALF + m * 16);
#pragma unroll
                for (int bj = 0; bj < 2; ++bj) {
                    const u32x4 ga = *(const u32x4*)(proj + r * NP + C_SNA + col0 + bj * HALF), gb = *(const u32x4*)(proj + r * NP + C_SGLA + col0 + bj * HALF);
#pragma unroll
                    for (int e = 0; e < 8; ++e) { const unsigned a2 = ga[e >> 1], b2 = gb[e >> 1];
                        const float sa = (e & 1) ? __uint_as_float(a2 & 0xffff0000u) : __uint_as_float(a2 << 16), sb = (e & 1) ? __uint_as_float(b2 & 0xffff0000u) : __uint_as_float(b2 << 16);
                        acc[ai][bj][m][e >> 2][e & 3] *= sa * __builtin_amdgcn_rcpf(sb); } }
                if (m == 3) asm volatile("" ::: "memory"); }
    }
    __device__ __forceinline__ void operator()(const f32x4 (&acc)[2][2][4][2], const Unit& u, int wr, int wc, int fr, int fq) const {
        const int row0 = u.pm * BM + wr * 64 + fr, col0 = u.pn * BM + wc * 32 + 8 * fq;
#pragma unroll
        for (int ai = 0; ai < 2; ++ai)
#pragma unroll
            for (int m = 0; m < 4; ++m) { const size_t r = (size_t)(row0 + ai * HALF + m * 16);
#pragma unroll
                for (int bj = 0; bj < 2; ++bj) {
                    const u32x4 gb = *(const u32x4*)(proj + r * NP + C_SGLA + col0 + bj * HALF);
                    float o[8];
#pragma unroll
                    for (int e = 0; e < 8; ++e) { const unsigned b2 = gb[e >> 1]; const float sb = (e & 1) ? __uint_as_float(b2 & 0xffff0000u) : __uint_as_float(b2 << 16);
                        o[e] = sb * acc[ai][bj][m][e >> 2][e & 3]; }
                    u32x4 w; w.x = cvt_pk_bf16(o[0], o[1]); w.y = cvt_pk_bf16(o[2], o[3]); w.z = cvt_pk_bf16(o[4], o[5]); w.w = cvt_pk_bf16(o[6], o[7]);
                    *(u32x4*)(O + r * DM + col0 + bj * HALF) = w; }
                if (m == 3) asm volatile("" ::: "memory"); }
    }
};

struct EpiOut {
    static constexpr bool PERM = false, AFTER_DRAIN = false, MID = false;
    const float* base; bf16_t* hb; float* ssq;
    __device__ __forceinline__ void operator()(const f32x4 (&acc)[2][2][4][2], const Unit& u, int wr, int wc, int fr, int fq) const {
        const int col0 = u.pn * BM + wc * 32 + 4 * fq;
#pragma unroll
        for (int ai = 0; ai < 2; ++ai) {
            f32x4 xv[4][2][2];
#pragma unroll
            for (int m = 0; m < 4; ++m) { const size_t r = (size_t)(u.pm * BM + ai * HALF + wr * 64 + m * 16 + fr);
#pragma unroll
                for (int bj = 0; bj < 2; ++bj)
#pragma unroll
                    for (int n = 0; n < 2; ++n) xv[m][bj][n] = *(const f32x4*)(base + r * DM + col0 + bj * HALF + n * 16); }
#pragma unroll
            for (int m = 0; m < 4; ++m) { const size_t r = (size_t)(u.pm * BM + ai * HALF + wr * 64 + m * 16 + fr); float s = 0.f;
#pragma unroll
                for (int bj = 0; bj < 2; ++bj)
#pragma unroll
                    for (int n = 0; n < 2; ++n) { const size_t off = r * DM + col0 + bj * HALF + n * 16;
                        const f32x4 h = xv[m][bj][n] + acc[ai][bj][m][n];
                        s += (h[0] * h[0] + h[1] * h[1]) + (h[2] * h[2] + h[3] * h[3]);
                        u32x2 w; w.x = cvt_pk_bf16(h[0], h[1]); w.y = cvt_pk_bf16(h[2], h[3]); *(u32x2*)(hb + off) = w; }
                s += __shfl_xor(s, 16); s += __shfl_xor(s, 32);
                if (fq == 0) atomicAdd(ssq + r, s); }
            asm volatile("" ::: "memory"); }
    }
};
struct EpiDownNorm {
    static constexpr bool PERM = false, AFTER_DRAIN = false, MID = false;
    const bf16_t* hb; float* out; float* ssq; unsigned* cnt; const float* gain;
    __device__ __forceinline__ void operator()(const f32x4 (&acc_)[2][2][4][2], const Unit& u, int wr, int wc, int fr, int fq) const {
        f32x4 (&acc)[2][2][4][2] = const_cast<f32x4 (&)[2][2][4][2]>(acc_);
        const int col0 = u.pn * BM + wc * 32 + 4 * fq;
#pragma unroll
        for (int ai = 0; ai < 2; ++ai) {
            u32x2 hv[4][2][2];
#pragma unroll
            for (int m = 0; m < 4; ++m) { const size_t r = (size_t)(u.pm * BM + ai * HALF + wr * 64 + m * 16 + fr);
#pragma unroll
                for (int bj = 0; bj < 2; ++bj)
#pragma unroll
                    for (int n = 0; n < 2; ++n) hv[m][bj][n] = *(const u32x2*)(hb + r * DM + col0 + bj * HALF + n * 16); }
#pragma unroll
            for (int m = 0; m < 4; ++m) { const size_t r = (size_t)(u.pm * BM + ai * HALF + wr * 64 + m * 16 + fr); float s = 0.f;
#pragma unroll
                for (int bj = 0; bj < 2; ++bj)
#pragma unroll
                    for (int n = 0; n < 2; ++n) { const u32x2 hw = hv[m][bj][n];
                        f32x4 h = acc[ai][bj][m][n];
                        h[0] += __uint_as_float(hw.x << 16); h[1] += __uint_as_float(hw.x & 0xffff0000u); h[2] += __uint_as_float(hw.y << 16); h[3] += __uint_as_float(hw.y & 0xffff0000u);
                        acc[ai][bj][m][n] = h; s += (h[0] * h[0] + h[1] * h[1]) + (h[2] * h[2] + h[3] * h[3]); }
                s += __shfl_xor(s, 16); s += __shfl_xor(s, 32);
                if (fq == 0) atomicAdd(ssq + r, s); }
            asm volatile("" ::: "memory"); }
        asm volatile("s_waitcnt vmcnt(0)" ::: "memory");
        if ((threadIdx.x & 63) == 0) __hip_atomic_fetch_add(cnt + u.pm, 1u, __ATOMIC_RELAXED, __HIP_MEMORY_SCOPE_AGENT);
        {   unsigned spins = 0;
            while ((unsigned)__builtin_amdgcn_readfirstlane((int)__hip_atomic_load(cnt + u.pm, __ATOMIC_RELAXED, __HIP_MEMORY_SCOPE_AGENT)) < 32u) { __builtin_amdgcn_s_sleep(2); if (++spins > (1u << 22)) break; } }
        asm volatile("" ::: "memory");
#pragma unroll
        for (int ai = 0; ai < 2; ++ai)
#pragma unroll
            for (int m = 0; m < 4; ++m) { const size_t r = (size_t)(u.pm * BM + ai * HALF + wr * 64 + m * 16 + fr);
                const float rstd = rsqrtf(__hip_atomic_load(ssq + r, __ATOMIC_RELAXED, __HIP_MEMORY_SCOPE_AGENT) * (1.0f / DM) + RMS_EPS);
#pragma unroll
                for (int bj = 0; bj < 2; ++bj)
#pragma unroll
                    for (int n = 0; n < 2; ++n) { const size_t off = r * DM + col0 + bj * HALF + n * 16; const f32x4 gg = *(const f32x4*)(gain + col0 + bj * HALF + n * 16);
                        *(f32x4*)(out + off) = acc[ai][bj][m][n] * rstd * gg; }
                asm volatile("" ::: "memory"); }
    }
};

struct EpiUp {
    static constexpr bool PERM = true, AFTER_DRAIN = false, MID = false;
    const float* ssq; bf16_t* O;
    __device__ __forceinline__ void operator()(const f32x4 (&acc)[2][2][4][2], const Unit& u, int wr, int wc, int fr, int fq) const {
        const int row0 = u.pm * BM + wr * 64 + fr, col0 = u.pn * BM + wc * 32 + 8 * fq;
#pragma unroll
        for (int ai = 0; ai < 2; ++ai)
#pragma unroll
            for (int m = 0; m < 4; ++m) { const size_t r = (size_t)(row0 + ai * HALF + m * 16);
                const float rstd = rsqrtf(ssq[r] * (1.0f / DM) + RMS_EPS);
#pragma unroll
                for (int bj = 0; bj < 2; ++bj) { f32x4 v0 = acc[ai][bj][m][0] * rstd, v1 = acc[ai][bj][m][1] * rstd;
#pragma unroll
                    for (int e = 0; e < 4; ++e) { const float a = fmaxf(v0[e], 0.f), b = fmaxf(v1[e], 0.f); v0[e] = a * a; v1[e] = b * b; }
                    u32x4 w; w.x = cvt_pk_bf16(v0[0], v0[1]); w.y = cvt_pk_bf16(v0[2], v0[3]); w.z = cvt_pk_bf16(v1[0], v1[1]); w.w = cvt_pk_bf16(v1[2], v1[3]);
                    const int col = col0 + bj * HALF;
                    *(u32x4*)(O + ((((r >> 8) * (DFF / 64) + (col >> 6)) * 256 + (r & 255)) * 64 + (col & 63))) = w; } }
    }
};

template <class Epi, class Sched, bool ALIGN_EPI = false, bool SP2 = false, bool TILED = false>
__device__ __forceinline__ void gemm_phase(PG8_LAS unsigned char* lds, const Gemm g, const Sched& S, const Epi& E) {
    int tid_ = threadIdx.x; asm volatile("" : "+v"(tid_));
    const int tid = tid_, wid = __builtin_amdgcn_readfirstlane(tid >> 6), lane = tid & 63, wr = wid >> 2, wc = wid & 3, fr = lane & 15, fq = lane >> 4;
    const int K = g.K, nt = K / BK;
    unsigned voffA[2], voffB[2];
#pragma unroll
    for (int i = 0; i < 2; ++i) { int R, C; stage_rc(tid * 16 + i * 8192, R, C); const int Rb = Epi::PERM ? ((R & ~31) + perm32(R & 31)) : R;
        const int rs = TILED ? BK : K; voffA[i] = (unsigned)(R * rs + C) * 2u; voffB[i] = (unsigned)(Rb * rs + C) * 2u; }
    const size_t kstep = TILED ? (size_t)(BM * BK * 2) : (size_t)(BK * 2);
    const size_t hstep = TILED ? (size_t)(HALF * BK * 2) : (size_t)HALF * K * 2;
    const size_t tstep = TILED ? (size_t)(K / BK) * (BM * BK * 2) : 2 * hstep;
    const unsigned ldsw = (unsigned)wid * 1024u;
    const int aoff = lds_byte(wr * 64 + fr, fq * 8), boff = lds_byte(wc * 32 + fr, fq * 8);
#define PG8_SA(b, h) (((b) * 2 + (h)) * HTB)
#define PG8_SB(b, h) ((4 + (b) * 2 + (h)) * HTB)
#define PG8_STAGE(bufoff, gbase, voff) do { _Pragma("unroll") for (int _i = 0; _i < 2; ++_i) \
        __builtin_amdgcn_global_load_lds((const unsigned*)((const char*)(gbase) + (voff)[_i]), (PG8_LAS unsigned*)(lds + (bufoff) + ldsw + _i * 8192), 16, 0, 0); } while (0)
#define PG8_LDA(dst, b, h) do { _Pragma("unroll") for (int m = 0; m < 4; ++m) _Pragma("unroll") for (int k = 0; k < 2; ++k) dst[m][k] = *(const PG8_LAS bf16x8*)(lds + PG8_SA(b, h) + aoff + m * 2048 + k * 1024); } while (0)
#define PG8_LDB(dst, b, h) do { _Pragma("unroll") for (int n = 0; n < 2; ++n) _Pragma("unroll") for (int k = 0; k < 2; ++k) dst[n][k] = *(const PG8_LAS bf16x8*)(lds + PG8_SB(b, h) + boff + n * 2048 + k * 1024); } while (0)
#define PG8_MMA(ai, bj, At, Bt) do { __builtin_amdgcn_s_setprio(1); _Pragma("unroll") for (int m = 0; m < 4; ++m) _Pragma("unroll") for (int n = 0; n < 2; ++n) _Pragma("unroll") for (int k = 0; k < 2; ++k) \
        acc[ai][bj][m][n] = __builtin_amdgcn_mfma_f32_16x16x32_bf16(Bt[n][k], At[m][k], acc[ai][bj][m][n], 0, 0, 0); __builtin_amdgcn_s_setprio(0); } while (0)
#define PG8_WAIT_V(n) asm volatile("s_waitcnt vmcnt(" #n ")" ::: "memory")
#define PG8_WAIT_L(n) asm volatile("s_waitcnt lgkmcnt(" #n ")" ::: "memory")
#define PG8_BAR __builtin_amdgcn_s_barrier()
#define PG8_SCHED __builtin_amdgcn_sched_barrier(0)
    Unit cur, nxt; int ui = 0;
    if (!S.next(0, cur)) return;
    f32x4 acc[2][2][4][2];
#pragma unroll
    for (int a = 0; a < 2; ++a)
#pragma unroll
        for (int b = 0; b < 2; ++b)
#pragma unroll
            for (int m = 0; m < 4; ++m)
#pragma unroll
                for (int n = 0; n < 2; ++n) acc[a][b][m][n] = (f32x4){0.f, 0.f, 0.f, 0.f};
    bf16x8 At[4][2], B0[2][2], B1[2][2];
    const char* cA = (const char*)g.A + (size_t)cur.pm * tstep; const char* cB = (const char*)g.Bt + (size_t)cur.pn * tstep;
    S.a_ready(cur);
    if constexpr (SP2) {
        PG8_STAGE(PG8_SB(0, 0), cB, voffB); PG8_STAGE(PG8_SB(0, 1), cB + hstep, voffB); PG8_STAGE(PG8_SA(0, 0), cA, voffA); PG8_STAGE(PG8_SA(0, 1), cA + hstep, voffA);
        if (wr == 1) PG8_BAR;
        PG8_WAIT_V(2); PG8_BAR;
        PG8_STAGE(PG8_SB(1, 0), cB + kstep, voffB); PG8_STAGE(PG8_SA(1, 0), cA + kstep, voffA); PG8_STAGE(PG8_SB(1, 1), cB + hstep + kstep, voffB);
        PG8_WAIT_V(6); PG8_BAR;
    } else {
        PG8_STAGE(PG8_SB(0, 0), cB, voffB); PG8_STAGE(PG8_SA(0, 0), cA, voffA); PG8_STAGE(PG8_SB(0, 1), cB + hstep, voffB); PG8_STAGE(PG8_SA(0, 1), cA + hstep, voffA);
        if (wr == 1) PG8_BAR;
        PG8_WAIT_V(4); PG8_BAR;
        PG8_STAGE(PG8_SB(1, 0), cB + kstep, voffB); PG8_STAGE(PG8_SA(1, 0), cA + kstep, voffA); PG8_STAGE(PG8_SB(1, 1), cB + hstep + kstep, voffB);
        PG8_WAIT_V(6); PG8_BAR;
    }
    for (;;) {
        const bool has_next = S.next(ui + 1, nxt);
        const char* nA = has_next ? (const char*)g.A + (size_t)nxt.pm * tstep : cA; const char* nB = has_next ? (const char*)g.Bt + (size_t)nxt.pn * tstep : cB;
        for (int t = 0; t < nt; t += 2) {
            const bool last = (t == nt - 2);
            const char* a1 = cA + (size_t)(t + 1) * kstep;
            const char* a2 = last ? nA : cA + (size_t)(t + 2) * kstep; const char* b2 = last ? nB : cB + (size_t)(t + 2) * kstep;
            const char* a3 = a2 + kstep; const char* b3 = b2 + kstep;
            if (last && has_next) S.a_ready(nxt);
            if constexpr (Epi::MID) { if (t == nt / 2) E.mid(acc, cur, wr, wc, fr, fq); }
            if constexpr (SP2) {
            PG8_LDB(B0, 0, 0); PG8_LDB(B1, 0, 1); PG8_SCHED; PG8_LDA(At, 0, 0); PG8_STAGE(PG8_SA(1, 1), a1 + hstep, voffA);
            PG8_WAIT_V(8); PG8_WAIT_L(0); PG8_BAR; PG8_MMA(0, 0, At, B0); PG8_MMA(0, 1, At, B1); PG8_BAR; PG8_SCHED;
            PG8_LDA(At, 0, 1); PG8_STAGE(PG8_SB(0, 0), b2, voffB); PG8_STAGE(PG8_SB(0, 1), b2 + hstep, voffB); PG8_STAGE(PG8_SA(0, 0), a2, voffA);
            PG8_WAIT_V(8); PG8_WAIT_L(0); PG8_BAR; PG8_MMA(1, 0, At, B0); PG8_MMA(1, 1, At, B1); PG8_BAR; PG8_SCHED;
            PG8_LDB(B0, 1, 0); PG8_LDB(B1, 1, 1); PG8_SCHED; PG8_LDA(At, 1, 0); PG8_STAGE(PG8_SA(0, 1), a2 + hstep, voffA);
            PG8_WAIT_V(8); PG8_WAIT_L(0); PG8_BAR; PG8_MMA(0, 0, At, B0); PG8_MMA(0, 1, At, B1); PG8_BAR; PG8_SCHED;
            PG8_LDA(At, 1, 1); PG8_STAGE(PG8_SB(1, 0), b3, voffB); PG8_STAGE(PG8_SB(1, 1), b3 + hstep, voffB); PG8_STAGE(PG8_SA(1, 0), a3, voffA);
            PG8_WAIT_V(8); PG8_WAIT_L(0); PG8_BAR; PG8_MMA(1, 0, At, B0); PG8_MMA(1, 1, At, B1); PG8_BAR; PG8_SCHED;
            } else {
            PG8_LDB(B0, 0, 0); PG8_SCHED; PG8_LDA(At, 0, 0); PG8_STAGE(PG8_SA(1, 1), a1 + hstep, voffA);
            PG8_WAIT_L(8); PG8_BAR; PG8_WAIT_L(0); PG8_MMA(0, 0, At, B0); PG8_BAR; PG8_SCHED;
            PG8_LDB(B1, 0, 1); PG8_STAGE(PG8_SB(0, 0), b2, voffB);
            PG8_BAR; PG8_WAIT_L(0); PG8_MMA(0, 1, At, B1); PG8_BAR;
            PG8_LDA(At, 0, 1); PG8_STAGE(PG8_SA(0, 0), a2, voffA);
            PG8_BAR; PG8_WAIT_L(0); PG8_MMA(1, 0, At, B0); PG8_BAR; PG8_SCHED;
            PG8_STAGE(PG8_SB(0, 1), b2 + hstep, voffB);
            PG8_WAIT_V(6); PG8_BAR; PG8_MMA(1, 1, At, B1); PG8_BAR;
            PG8_LDB(B0, 1, 0); PG8_SCHED; PG8_LDA(At, 1, 0); PG8_STAGE(PG8_SA(0, 1), a2 + hstep, voffA);
            PG8_WAIT_L(8); PG8_BAR; PG8_WAIT_L(0); PG8_MMA(0, 0, At, B0); PG8_BAR; PG8_SCHED;
            PG8_LDB(B1, 1, 1); PG8_STAGE(PG8_SB(1, 0), b3, voffB);
            PG8_BAR; PG8_WAIT_L(0); PG8_MMA(0, 1, At, B1); PG8_BAR;
            PG8_LDA(At, 1, 1); PG8_STAGE(PG8_SA(1, 0), a3, voffA);
            PG8_BAR; PG8_WAIT_L(0); PG8_MMA(1, 0, At, B0); PG8_BAR; PG8_SCHED;
            PG8_STAGE(PG8_SB(1, 1), b3 + hstep, voffB);
            PG8_WAIT_V(6); PG8_BAR; PG8_MMA(1, 1, At, B1); PG8_BAR;
            }
        }
        if constexpr (ALIGN_EPI) { if (wr == 0) PG8_BAR; }
        if constexpr (!Epi::AFTER_DRAIN) { E(acc, cur, wr, wc, fr, fq); S.done(cur); }
        if (!has_next) break;
#pragma unroll
        for (int a = 0; a < 2; ++a)
#pragma unroll
            for (int b = 0; b < 2; ++b)
#pragma unroll
                for (int m = 0; m < 4; ++m)
#pragma unroll
                    for (int n = 0; n < 2; ++n) acc[a][b][m][n] = (f32x4){0.f, 0.f, 0.f, 0.f};
        cur = nxt; cA = nA; cB = nB; ++ui;
        if constexpr (ALIGN_EPI) { if (wr == 1) PG8_BAR; }
    }
    PG8_WAIT_V(0);
    if constexpr (!ALIGN_EPI) { if (wr == 0) PG8_BAR; }
    PG8_BAR;
    if constexpr (Epi::AFTER_DRAIN) { E.fused(acc, cur, wr, wc, fr, fq, lds, wid, lane); S.done(cur); }
#undef PG8_SA
#undef PG8_SB
#undef PG8_STAGE
#undef PG8_LDA
#undef PG8_LDB
#undef PG8_MMA
#undef PG8_WAIT_V
#undef PG8_WAIT_L
#undef PG8_BAR
#undef PG8_SCHED
}
}

#define LAS __attribute__((address_space(3)))
#define DI __device__ __forceinline__
typedef unsigned short bf16;
typedef short bf16x8 __attribute__((ext_vector_type(8)));
typedef short s16x4 __attribute__((ext_vector_type(4)));
typedef float f32x4 __attribute__((ext_vector_type(4)));
typedef float f32x2 __attribute__((ext_vector_type(2)));
typedef unsigned u32x4 __attribute__((ext_vector_type(4)));
typedef unsigned u32x2 __attribute__((ext_vector_type(2)));
typedef __bf16 bf16v2 __attribute__((ext_vector_type(2)));
constexpr int NWAVES = 8, NTHR = 512;
constexpr int LDS_BYTES = 155648;

constexpr size_t MiB = 1u << 20;
constexpr size_t WS_CTL = 0, CTL_BYTES = 2 * MiB;
constexpr size_t WS_SSQ1 = 512 * 1024, WS_SSQ2 = 1024 * 1024;
constexpr size_t WS_WIN = 2 * MiB, WS_WNA = 13 * MiB, WS_WGLA = 14 * MiB, WS_WOUT = 15 * MiB, WS_WUP = 17 * MiB, WS_WDOWN = 25 * MiB, WS_BIAS = 33 * MiB;
constexpr size_t WS_U = 34 * MiB;
constexpr size_t WS_NAO = 162 * MiB, WS_GLAO = 226 * MiB;
constexpr size_t WS_PROJ = 290 * MiB;
constexpr size_t WS_END = 962 * MiB;

DI float bf2f(unsigned short b) { return __uint_as_float((unsigned)b << 16); }
DI unsigned pk2(float lo, float hi) { f32x2 v = {lo, hi}; bf16v2 b = __builtin_convertvector(v, bf16v2); return __builtin_bit_cast(unsigned, b); }
DI unsigned short f2bf(float x) { return (unsigned short)(pk2(x, 0.f) & 0xffffu); }
DI float wave_sum(float v) {
#pragma unroll
    for (int o = 1; o < 64; o <<= 1) v += __shfl_xor(v, o);
    return v;
}
#define LDS_WAIT() asm volatile("s_waitcnt lgkmcnt(0)" ::: "memory")
#define BAR_LDS() do { asm volatile("s_waitcnt lgkmcnt(0)" ::: "memory"); __builtin_amdgcn_s_barrier(); asm volatile("" ::: "memory"); } while (0)
#define MFMA32(a, b, c) __builtin_amdgcn_mfma_f32_16x16x32_bf16((a), (b), (c), 0, 0, 0)
#define MFMA16(a, b, c) __builtin_amdgcn_mfma_f32_16x16x16bf16_1k((a), (b), (c), 0, 0, 0)

struct Args {
    const float* x[2]; const float* norm_mix_g; const float* w_in; const float* b_in; const float* na_rpb;
    const float* gk_w[2]; const float* gk_b[2]; const float* gla_norm_g; const float* w_br_na; const float* w_br_gla; const float* w_out;
    const float* norm_mlp_g; const float* w_up; const float* w_down; const float* norm_final_g;
    float* out; unsigned char* ws; int ph_lo, ph_hi, coop, pad;
};

template <int MODE>
DI void transpose_item(const float* W, int K, int N, bf16* WT, LAS float* scr, int item, int lane, const float* g, int ldk = 0, int koff = 0) {
    if (ldk == 0) ldk = K;
    const int nblk = N / 32, kb = item / nblk, nb = item % nblk, k0 = 64 * kb, n0 = 32 * nb;
#pragma unroll 8
    for (int i = 0; i < 32; ++i) { const int kk = 2 * i + (lane >> 5); float v = W[(size_t)(k0 + kk) * N + n0 + (lane & 31)]; if (MODE == 2) v *= g[k0 + kk]; scr[kk * 33 + (lane & 31)] = v; }
    LDS_WAIT();
    int d0 = n0; if (MODE == 1) d0 = (n0 < 3072) ? n0 : ((n0 < 3104) ? (C_LR + (n0 - 3072)) : (n0 - 32));
    const int c = lane & 7;
#pragma unroll
    for (int j = 0; j < 4; ++j) { const int n = (lane >> 3) + 8 * j; const LAS float* s = scr + (8 * c) * 33 + n;
        u32x4 o; o.x = pk2(s[0 * 33], s[1 * 33]); o.y = pk2(s[2 * 33], s[3 * 33]); o.z = pk2(s[4 * 33], s[5 * 33]); o.w = pk2(s[6 * 33], s[7 * 33]);
        if (MODE == 3) *(u32x4*)(WT + ((((size_t)((d0 + n) >> 8) * (K / 64) + (k0 >> 6)) * 256 + ((d0 + n) & 255)) * 64 + 8 * c)) = o;
        else *(u32x4*)(WT + (size_t)(d0 + n) * ldk + koff + k0 + 8 * c) = o; }
    LDS_WAIT();
}
DI void rms_row2_to_bf16(const float* xrow0, const float* xrow1, const float* g, bf16* orow0, bf16* orow1, int lane) {
    const f32x4* xr0 = (const f32x4*)xrow0 + lane; const f32x4* xr1 = (const f32x4*)xrow1 + lane; const f32x4* gr = (const f32x4*)g + lane;
    f32x4 v0[4], v1[4]; float s0 = 0.f, s1 = 0.f;
#pragma unroll
    for (int j = 0; j < 4; ++j) { v0[j] = __builtin_nontemporal_load(xr0 + 64 * j); v1[j] = __builtin_nontemporal_load(xr1 + 64 * j); }
#pragma unroll
    for (int j = 0; j < 4; ++j) { s0 += (v0[j].x * v0[j].x + v0[j].y * v0[j].y) + (v0[j].z * v0[j].z + v0[j].w * v0[j].w); s1 += (v1[j].x * v1[j].x + v1[j].y * v1[j].y) + (v1[j].z * v1[j].z + v1[j].w * v1[j].w); }
    const float r0 = rsqrtf(wave_sum(s0) * (1.f / DM) + RMS_EPS), r1 = rsqrtf(wave_sum(s1) * (1.f / DM) + RMS_EPS);
    u32x2* o0 = (u32x2*)orow0 + lane; u32x2* o1 = (u32x2*)orow1 + lane;
#pragma unroll
    for (int j = 0; j < 4; ++j) { const f32x4 gg = gr[64 * j]; u32x2 w;
        w.x = pk2(v0[j].x * r0 * gg.x, v0[j].y * r0 * gg.y); w.y = pk2(v0[j].z * r0 * gg.z, v0[j].w * r0 * gg.w); o0[64 * j] = w;
        w.x = pk2(v1[j].x * r1 * gg.x, v1[j].y * r1 * gg.y); w.y = pk2(v1[j].z * r1 * gg.z, v1[j].w * r1 * gg.w); o1[64 * j] = w; }
}
DI void rms_row_to_bf16(const float* xrow, const float* g, bf16* orow, int lane) {
    const f32x4* xr = (const f32x4*)xrow + lane; const f32x4* gr = (const f32x4*)g + lane;
    f32x4 v[4]; float s = 0.f;
#pragma unroll
    for (int j = 0; j < 4; ++j) { v[j] = xr[64 * j]; s += (v[j].x * v[j].x + v[j].y * v[j].y) + (v[j].z * v[j].z + v[j].w * v[j].w); }
    const float rstd = rsqrtf(wave_sum(s) * (1.f / DM) + RMS_EPS);
    u32x2* o8 = (u32x2*)orow + lane;
#pragma unroll
    for (int j = 0; j < 4; ++j) { const f32x4 gg = gr[64 * j]; u32x2 w; w.x = pk2(v[j].x * rstd * gg.x, v[j].y * rstd * gg.y); w.y = pk2(v[j].z * rstd * gg.z, v[j].w * rstd * gg.w); o8[64 * j] = w; }
}
DI void final_row(float* row, const float* g, float ssq, int lane) {
    f32x4* xr = (f32x4*)row + lane; const f32x4* gr = (const f32x4*)g + lane;
    const float rstd = rsqrtf(ssq * (1.f / DM) + RMS_EPS);
#pragma unroll
    for (int j = 0; j < 4; ++j) { f32x4 v = xr[64 * j]; const f32x4 gg = gr[64 * j]; v = v * rstd; v = v * gg; xr[64 * j] = v; }
}

constexpr int GL_P = 144;
constexpr int GL_QD = 0, GL_KI = 9216, GL_KDT = 18432, GL_VT = 27648, GL_DEC = 46080, GL_LR = 47104, GL_CL = 51200, GL_OB = 52224, GL_OBP = 272, GL_DIR = 52224 + 64 * 272;
constexpr int GSEG = 1024;
DI float fexp_(float x) { return __builtin_amdgcn_exp2f(1.4426950408889634f * x); }
DI float logsigmoid_(float x) { return fminf(x, 0.f) - 0.6931471805599453f * __builtin_amdgcn_logf(1.0f + fexp_(-fabsf(x))); }

DI void gla_pass1(LAS unsigned char* lds, const Args& A, const bf16* proj, bf16* scratch, bf16* QS, bf16* HT, float* DD, int T, int b, int h, int k, int tid_in) {
    int tid = tid_in; asm volatile("" : "+v"(tid));
    const int lane = tid & 63, wave = tid >> 6, dir = wave >> 2, c = wave & 3, d = lane, g = lane >> 4, l15 = lane & 15;
    LAS unsigned char* L = lds + dir * GL_DIR;
    constexpr int NI = GSEG / 64;
    const size_t rowb = (size_t)b * T + (size_t)k * GSEG;
    const int sidx = ((b * 4 + h) * (T / GSEG) + k) * 2 + dir;
    unsigned gkp[8];
#pragma unroll
    for (int j = 0; j < 8; ++j) gkp[j] = pk2(A.gk_w[dir][(2 * j) * 256 + h * 64 + d], A.gk_w[dir][(2 * j + 1) * 256 + h * 64 + d]);
    const float gkb = A.gk_b[dir][h * 64 + d];
    f32x4 S[4][2];
#pragma unroll
    for (int mt = 0; mt < 4; ++mt)
#pragma unroll
        for (int nt = 0; nt < 2; ++nt) S[mt][nt] = (f32x4){0.f, 0.f, 0.f, 0.f};
    const int vs = c * 32;
    const int tl = tid & 255;
    float carry = 0.f;
    unsigned short qraw[16], kraw[16]; u32x2 lrraw; u32x4 vraw[4];
#define GLA_ROW(s) (rowb + (size_t)(dir ? (GSEG - 1 - (s)) : (s)))
#define GLA_PREFETCH(it) do { const int s0_ = (it) * 64; \
        _Pragma("unroll") for (int i = 0; i < 16; ++i) { const bf16* p_ = proj + GLA_ROW(s0_ + c * 16 + i) * NP + h * 64 + d; qraw[i] = p_[C_GQ]; kraw[i] = p_[C_GK]; } \
        lrraw = *(const u32x2*)(proj + GLA_ROW(s0_ + c * 16 + (lane >> 2)) * NP + C_LR + dir * 16 + (lane & 3) * 4); \
        _Pragma("unroll") for (int q = 0; q < 4; ++q) { const int idx_ = tl + 256 * q; vraw[q] = *(const u32x4*)(proj + GLA_ROW(s0_ + (idx_ & 63)) * NP + C_GV + h * 128 + (idx_ >> 6) * 8); } } while (0)
#define GLA_FLUSH(itf) do { _Pragma("unroll") for (int q_ = 0; q_ < 4; ++q_) { const int idx_ = tl + 256 * q_, tk_ = idx_ >> 4, ch_ = idx_ & 15; \
        *(u32x4*)(scratch + GLA_ROW((itf) * 64 + tk_) * DM + dir * 512 + h * 128 + ch_ * 8) = *(const LAS u32x4*)(L + GL_OB + tk_ * GL_OBP + ch_ * 16); } } while (0)
    GLA_PREFETCH(0);
#pragma unroll 1
    for (int it = 0; it < NI; ++it) {
        BAR_LDS();
        if (it > 0) GLA_FLUSH(it - 1);
        *(LAS u32x2*)(L + GL_LR + (c * 16 + (lane >> 2)) * 32 + (lane & 3) * 8) = lrraw;
        LDS_WAIT();
        float qdv[16];
        {   float cum = 0.f; float kinv[16];
#pragma unroll
            for (int i = 0; i < 16; ++i) {
                const LAS u32x4* lr4 = (const LAS u32x4*)(L + GL_LR + (c * 16 + i) * 32);
                const u32x4 la_ = lr4[0], lb_ = lr4[1];
                const unsigned lw[8] = {la_.x, la_.y, la_.z, la_.w, lb_.x, lb_.y, lb_.z, lb_.w};
                float pre = gkb;
#pragma unroll
                for (int j = 0; j < 8; ++j) pre = __builtin_amdgcn_fdot2_f32_bf16(__builtin_bit_cast(bf16v2, lw[j]), __builtin_bit_cast(bf16v2, gkp[j]), pre, false);
                cum += logsigmoid_(pre) * (1.0f / 16.0f);
                const float e = fexp_(cum); qdv[i] = bf2f(qraw[i]) * e;
                kinv[i] = bf2f(kraw[i]) * __builtin_amdgcn_rcpf(e);
                *(LAS unsigned short*)(L + GL_QD + (c * 16 + i) * GL_P + d * 2) = f2bf(qdv[i]);
                *(LAS unsigned short*)(L + GL_KI + (c * 16 + i) * GL_P + d * 2) = f2bf(kinv[i]);
            }
            const float eL = fexp_(cum);
            ((LAS float*)(L + GL_DEC))[c * 64 + d] = eL;
            ((LAS float*)(L + GL_CL))[c * 64 + d] = cum;
            u32x4 w0, w1;
            w0.x = pk2(kinv[0] * eL, kinv[1] * eL); w0.y = pk2(kinv[2] * eL, kinv[3] * eL); w0.z = pk2(kinv[4] * eL, kinv[5] * eL); w0.w = pk2(kinv[6] * eL, kinv[7] * eL);
            w1.x = pk2(kinv[8] * eL, kinv[9] * eL); w1.y = pk2(kinv[10] * eL, kinv[11] * eL); w1.z = pk2(kinv[12] * eL, kinv[13] * eL); w1.w = pk2(kinv[14] * eL, kinv[15] * eL);
            *(LAS u32x4*)(L + GL_KDT + d * GL_P + c * 32) = w0; *(LAS u32x4*)(L + GL_KDT + d * GL_P + c * 32 + 16) = w1;
        }
#pragma unroll
        for (int q = 0; q < 4; ++q) { const int idx = tl + 256 * q, tk = idx & 63, v0 = (idx >> 6) * 8;
#pragma unroll
            for (int e = 0; e < 8; ++e) { const unsigned w = vraw[q][e >> 1]; *(LAS unsigned short*)(L + GL_VT + (v0 + e) * GL_P + tk * 2) = (unsigned short)((e & 1) ? (w >> 16) : (w & 0xffffu)); } }
        BAR_LDS();
        {   const LAS float* CL = (const LAS float*)(L + GL_CL) + d; const float c0 = CL[0], c1 = CL[64], c2 = CL[128], c3 = CL[192];
            const float off = carry + ((c > 0) ? c0 : 0.f) + ((c > 1) ? c1 : 0.f) + ((c > 2) ? c2 : 0.f);
            carry += (c0 + c1) + (c2 + c3);
            const float eo = fexp_(off);
#pragma unroll
            for (int i = 0; i < 16; ++i) QS[GLA_ROW(it * 64 + c * 16 + i) * 512 + dir * 256 + h * 64 + d] = f2bf(qdv[i] * eo); }
#pragma unroll
        for (int cc = 0; cc < 4; ++cc) {
            const int trow = cc * 16 + l15;
            f32x4 X = (f32x4){0.f, 0.f, 0.f, 0.f};
#pragma unroll
            for (int ks = 0; ks < 2; ++ks) { const bf16x8 ki = *(const LAS bf16x8*)(L + GL_KI + trow * GL_P + (ks * 32 + 8 * g) * 2), qd = *(const LAS bf16x8*)(L + GL_QD + trow * GL_P + (ks * 32 + 8 * g) * 2);
                X = MFMA32(ki, qd, X); }
#pragma unroll
            for (int r = 0; r < 4; ++r) if (4 * g + r > l15) X[r] = 0.f;
            u32x2 pp; pp.x = pk2(X[0], X[1]); pp.y = pk2(X[2], X[3]);
            const s16x4 P = __builtin_bit_cast(s16x4, pp);
            s16x4 vt[2]; f32x4 o[2];
#pragma unroll
            for (int nt = 0; nt < 2; ++nt) { vt[nt] = *(const LAS s16x4*)(L + GL_VT + (vs + 16 * nt + l15) * GL_P + (cc * 16 + 4 * g) * 2);
                o[nt] = MFMA16(P, vt[nt], ((f32x4){0.f, 0.f, 0.f, 0.f})); }
#pragma unroll
            for (int ks = 0; ks < 2; ++ks) {
                const u32x2 qlo = *(const LAS u32x2*)(L + GL_QD + trow * GL_P + (32 * ks + 4 * g) * 2), qhi = *(const LAS u32x2*)(L + GL_QD + trow * GL_P + (32 * ks + 16 + 4 * g) * 2);
                const u32x4 qq = (u32x4){qlo.x, qlo.y, qhi.x, qhi.y}; const bf16x8 qa = __builtin_bit_cast(bf16x8, qq);
#pragma unroll
                for (int nt = 0; nt < 2; ++nt) { const f32x4 s0 = S[2 * ks][nt], s1 = S[2 * ks + 1][nt];
                    const u32x4 sw = (u32x4){pk2(s0[0], s0[1]), pk2(s0[2], s0[3]), pk2(s1[0], s1[1]), pk2(s1[2], s1[3])};
                    o[nt] = MFMA32(qa, __builtin_bit_cast(bf16x8, sw), o[nt]); } }
#pragma unroll
            for (int r = 0; r < 4; ++r) { LAS unsigned short* op = (LAS unsigned short*)(L + GL_OB + (cc * 16 + 4 * g + r) * GL_OBP + (vs + l15) * 2); op[0] = f2bf(o[0][r]); op[16] = f2bf(o[1][r]); }
#pragma unroll
            for (int mt = 0; mt < 4; ++mt) { const f32x4 dec = *(const LAS f32x4*)(L + GL_DEC + (cc * 64 + 16 * mt + 4 * g) * 4);
                const s16x4 kd = *(const LAS s16x4*)(L + GL_KDT + (16 * mt + l15) * GL_P + (cc * 16 + 4 * g) * 2);
#pragma unroll
                for (int nt = 0; nt < 2; ++nt) { f32x4 sv = S[mt][nt]; sv = sv * dec; S[mt][nt] = MFMA16(kd, vt[nt], sv); } }
            if (cc == 1 && it + 1 < NI) GLA_PREFETCH(it + 1);
        }
    }
    BAR_LDS();
    GLA_FLUSH(NI - 1);
#undef GLA_FLUSH
#undef GLA_PREFETCH
#undef GLA_ROW
#pragma unroll
    for (int mt = 0; mt < 4; ++mt)
#pragma unroll
        for (int nt = 0; nt < 2; ++nt) { u32x2 w; w.x = pk2(S[mt][nt][0], S[mt][nt][1]); w.y = pk2(S[mt][nt][2], S[mt][nt][3]);
            *(u32x2*)(HT + ((size_t)sidx * 128 + vs + 16 * nt + l15) * 64 + 16 * mt + 4 * g) = w; }
    if (c == 0) DD[(size_t)sidx * 64 + d] = fexp_(carry);
    __syncthreads();
}

constexpr int G2_S0 = 0, G2_OT = 36864, G2_OTP = 132;
DI void gla_pass2(LAS unsigned char* lds, const Args& A, const bf16* proj, const bf16* scratch, const bf16* QS, const bf16* HT, const float* DD, bf16* glao, int T, int b, int h, int k, int tid_in) {
    int tid = tid_in; asm volatile("" : "+v"(tid));
    const int lane = tid & 63, wave = tid >> 6, g = lane >> 4, l15 = lane & 15;
    const int nseg = T / GSEG;
    const size_t rowb = (size_t)b * T + (size_t)k * GSEG;
    const int ntk = tid >> 3, nvc = tid & 7;
    bf16x8 AF[4][2][2]; u32x4 SC[2][2]; u32x4 gw[2];
#define G2_LOAD(grp) do { _Pragma("unroll") for (int mt_ = 0; mt_ < 4; ++mt_) { const size_t r0_ = rowb + (grp) * 64 + mt_ * 16; \
        _Pragma("unroll") for (int dir_ = 0; dir_ < 2; ++dir_) _Pragma("unroll") for (int ks_ = 0; ks_ < 2; ++ks_) AF[mt_][dir_][ks_] = *(const bf16x8*)(QS + (r0_ + l15) * 512 + dir_ * 256 + h * 64 + ks_ * 32 + 8 * g); \
        } \
        { const u32x4* gp_ = (const u32x4*)(proj + (rowb + (grp) * 64 + ntk) * NP + C_GG + h * 128 + nvc * 16); gw[0] = gp_[0]; gw[1] = gp_[1]; \
          const u32x4* sp_ = (const u32x4*)(scratch + (rowb + (grp) * 64 + ntk) * DM + h * 128 + nvc * 16); SC[0][0] = sp_[0]; SC[0][1] = sp_[1]; SC[1][0] = sp_[64]; SC[1][1] = sp_[65]; } } while (0)
    G2_LOAD(0);
    {   const int dir = tid >> 8, oct = tid & 7, vq = (tid & 255) >> 3;
        float acc[4][8], w[8];
#pragma unroll
        for (int e = 0; e < 8; ++e) { w[e] = 1.f;
#pragma unroll
            for (int j = 0; j < 4; ++j) acc[j][e] = 0.f; }
        const int nsteps = dir ? (nseg - 1 - k) : k;
        const int sbase = ((b * 4 + h) * nseg) * 2 + dir, mstep = dir ? 2 : -2;
        int si = sbase + 2 * (dir ? (k + 1) : (k - 1));
        u32x4 hc[4]; f32x4 dc[2];
#define G2_LDH(sidx, hh, dd) do { _Pragma("unroll") for (int j_ = 0; j_ < 4; ++j_) hh[j_] = *(const u32x4*)(HT + ((size_t)(sidx) * 128 + vq + 32 * j_) * 64 + oct * 8); \
        dd[0] = *(const f32x4*)(DD + (size_t)(sidx) * 64 + oct * 8); dd[1] = *(const f32x4*)(DD + (size_t)(sidx) * 64 + oct * 8 + 4); } while (0)
        if (nsteps > 0) G2_LDH(si, hc, dc);
#pragma unroll 1
        for (int st = 0; st < nsteps; ++st) {
            u32x4 hn[4]; f32x4 dn[2];
#pragma unroll
            for (int j = 0; j < 4; ++j) hn[j] = hc[j];
            dn[0] = dc[0]; dn[1] = dc[1];
            si += mstep;
            if (st + 1 < nsteps) G2_LDH(si, hn, dn);
#pragma unroll
            for (int j = 0; j < 4; ++j)
#pragma unroll
                for (int e = 0; e < 8; ++e) { const unsigned x = hc[j][e >> 1]; const float hv = (e & 1) ? __uint_as_float(x & 0xffff0000u) : __uint_as_float(x << 16); acc[j][e] += w[e] * hv; }
#pragma unroll
            for (int e = 0; e < 8; ++e) w[e] *= (e < 4) ? dc[0][e & 3] : dc[1][e & 3];
#pragma unroll
            for (int j = 0; j < 4; ++j) hc[j] = hn[j];
            dc[0] = dn[0]; dc[1] = dn[1];
        }
#undef G2_LDH
#pragma unroll
        for (int j = 0; j < 4; ++j) *(LAS u32x4*)(lds + G2_S0 + dir * 18432 + (vq + 32 * j) * GL_P + oct * 16) =
            (u32x4){pk2(acc[j][0], acc[j][1]), pk2(acc[j][2], acc[j][3]), pk2(acc[j][4], acc[j][5]), pk2(acc[j][6], acc[j][7])};
    }
    BAR_LDS();
    bf16x8 Bf[2][2];
#pragma unroll
    for (int dir = 0; dir < 2; ++dir)
#pragma unroll
        for (int ks = 0; ks < 2; ++ks) Bf[dir][ks] = *(const LAS bf16x8*)(lds + G2_S0 + dir * 18432 + (16 * wave + l15) * GL_P + (ks * 32 + 8 * g) * 2);
    LAS float* OT = (LAS float*)(lds + G2_OT);
    f32x4 gn[4];
#pragma unroll
    for (int j = 0; j < 4; ++j) gn[j] = *(const f32x4*)(A.gla_norm_g + nvc * 16 + 4 * j);
#pragma unroll 1
    for (int grp = 0; grp < GSEG / 64; ++grp) {
#pragma unroll
        for (int mtile = 0; mtile < 4; ++mtile) {
            f32x4 acc = (f32x4){0.f, 0.f, 0.f, 0.f};
#pragma unroll
            for (int dir = 0; dir < 2; ++dir)
#pragma unroll
                for (int ks = 0; ks < 2; ++ks) acc = MFMA32(AF[mtile][dir][ks], Bf[dir][ks], acc);
#pragma unroll
            for (int r = 0; r < 4; ++r) OT[(mtile * 16 + 4 * g + r) * G2_OTP + 16 * wave + l15] = acc[r];
        }
        const u32x4 gw0 = gw[0], gw1 = gw[1], sf0 = SC[0][0], sf1 = SC[0][1], sb0 = SC[1][0], sb1 = SC[1][1];
        if (grp + 1 < GSEG / 64) G2_LOAD(grp + 1);
        BAR_LDS();
        {   const size_t row = rowb + grp * 64 + ntk; f32x4 sv[4]; float ss = 0.f;
#pragma unroll
            for (int j = 0; j < 4; ++j) { const u32x4 cf = (j < 2) ? sf0 : sf1, cb = (j < 2) ? sb0 : sb1; const unsigned f0 = cf[2 * (j & 1)], f1 = cf[2 * (j & 1) + 1], b0 = cb[2 * (j & 1)], b1 = cb[2 * (j & 1) + 1];
                f32x4 lo; lo.x = __uint_as_float(f0 << 16) + __uint_as_float(b0 << 16); lo.y = __uint_as_float(f0 & 0xffff0000u) + __uint_as_float(b0 & 0xffff0000u);
                lo.z = __uint_as_float(f1 << 16) + __uint_as_float(b1 << 16); lo.w = __uint_as_float(f1 & 0xffff0000u) + __uint_as_float(b1 & 0xffff0000u);
                sv[j] = *(const LAS f32x4*)(OT + ntk * G2_OTP + nvc * 16 + 4 * j) + lo; ss += (sv[j].x * sv[j].x + sv[j].y * sv[j].y) + (sv[j].z * sv[j].z + sv[j].w * sv[j].w); }
            ss += __shfl_xor(ss, 1); ss += __shfl_xor(ss, 2); ss += __shfl_xor(ss, 4);
            const float rstd = rsqrtf(ss * (1.0f / 128.0f) + RMS_EPS);
            u32x4* op = (u32x4*)(glao + row * DM + h * 128 + nvc * 16);
#pragma unroll
            for (int j2 = 0; j2 < 2; ++j2) { const u32x4 gq = j2 ? gw1 : gw0; const f32x4 a = sv[2 * j2] * rstd * gn[2 * j2], bb = sv[2 * j2 + 1] * rstd * gn[2 * j2 + 1];
                u32x4 w;
                w.x = pk2(a.x * __uint_as_float(gq.x << 16), a.y * __uint_as_float(gq.x & 0xffff0000u)); w.y = pk2(a.z * __uint_as_float(gq.y << 16), a.w * __uint_as_float(gq.y & 0xffff0000u));
                w.z = pk2(bb.x * __uint_as_float(gq.z << 16), bb.y * __uint_as_float(gq.z & 0xffff0000u)); w.w = pk2(bb.z * __uint_as_float(gq.w << 16), bb.w * __uint_as_float(gq.w & 0xffff0000u));
                op[j2] = w; }
        }
        BAR_LDS();
    }
#undef G2_LOAD
}

constexpr int NA_K = 0, NA_V = 65536, NA_MRG = 131072, NA_BIAS = 131072 + 18432, NA_ITEM = NA_BIAS + 1920;
static_assert(NA_ITEM + 64 <= LDS_BYTES, "NA LDS map");
DI void na_phase(LAS unsigned char* lds, const Args& A, const bf16* proj, bf16* nao, int T, int nB, unsigned* counter, int tid_in) {
    int tid = tid_in; asm volatile("" : "+v"(tid));
    const int lane = tid & 63, wave = tid >> 6, qg = wave & 3, kh = wave >> 2, g = lane >> 4, l15 = lane & 15;
    constexpr int NAR = 32;
    const int rows = T / 64, nr = rows / NAR, nitems = nB * 8 * nr;
    const int cq = 16 * qg + l15;
    const int cs0 = (qg == 0) ? 0 : ((qg == 1) ? 8 : ((qg == 2) ? 24 : 32));
    const int csq = min(max(cq - 8, 0), 48);
    const int lc = tid >> 3, lc8 = tid & 7;
    for (int item = (int)blockIdx.x; item < nitems; item += (int)gridDim.x) {
        __syncthreads();
        const int b = item / (8 * nr), h = (item / nr) & 7, r0 = (item % nr) * NAR;
        const size_t rowb = (size_t)b * T;
        if (tid < 465) ((LAS float*)(lds + NA_BIAS))[tid] = A.na_rpb[h * 465 + tid];
#define NA_RS(r) min(max((r) - 4, 0), rows - 8)
#define NA_LOADROW(kr, kreg, vreg) do { const bf16* p_ = proj + (rowb + (size_t)(kr) * 64 + lc) * NP + h * 64 + lc8 * 8; kreg = *(const u32x4*)(p_ + C_NAK); vreg = *(const u32x4*)(p_ + C_NAV); } while (0)
#define NA_STOREROW(kr, kreg, vreg) do { const int sl_ = (kr) & 7; \
            *(LAS u32x4*)(lds + NA_K + sl_ * 8192 + lc * 128 + ((lc8 ^ ((lc >> 1) & 7)) * 16)) = kreg; \
            _Pragma("unroll") for (int e = 0; e < 8; ++e) { const int d_ = lc8 * 8 + e; const unsigned w_ = vreg[e >> 1]; \
                *(LAS unsigned short*)(lds + NA_V + sl_ * 8192 + d_ * 128 + (((lc >> 2) ^ (2 * ((d_ >> 1) & 7))) * 8) + (lc & 3) * 2) = (unsigned short)((e & 1) ? (w_ >> 16) : (w_ & 0xffffu)); } } while (0)
        {   const int rs0 = NA_RS(r0); u32x4 kr8[8], vr8[8];
#pragma unroll
            for (int i = 0; i < 8; ++i) NA_LOADROW(rs0 + i, kr8[i], vr8[i]);
#pragma unroll
            for (int i = 0; i < 8; ++i) NA_STOREROW(rs0 + i, kr8[i], vr8[i]); }
        bf16x8 qf[2], qn[2];
#define NA_LOADQ(r, dst) do { const bf16* p_ = proj + (rowb + (size_t)(r) * 64 + cq) * NP + C_NAQ + h * 64 + 8 * g; dst[0] = *(const bf16x8*)p_; dst[1] = *(const bf16x8*)(p_ + 32); } while (0)
        NA_LOADQ(r0, qf);
        __syncthreads();
#pragma unroll 1
        for (int r = r0; r < r0 + NAR; ++r) {
            const int rs = NA_RS(r);
            const bool more = (r + 1 < r0 + NAR), need_new = more && (NA_RS(r + 1) != rs);
            u32x4 kreg = (u32x4){0u, 0u, 0u, 0u}, vreg = (u32x4){0u, 0u, 0u, 0u};
            if (need_new) NA_LOADROW(rs + 8, kreg, vreg);
            if (more) NA_LOADQ(r + 1, qn);
            f32x4 sT[4][2]; float mx = -INFINITY;
            const LAS float* BI = (const LAS float*)(lds + NA_BIAS);
#pragma unroll
            for (int rr = 0; rr < 4; ++rr) { const int kr = rs + 4 * kh + rr, sl = kr & 7;
#pragma unroll
                for (int ct = 0; ct < 2; ++ct) { const int cm = cs0 + 16 * ct + l15; f32x4 acc = (f32x4){0.f, 0.f, 0.f, 0.f};
#pragma unroll
                    for (int ks = 0; ks < 2; ++ks) { const bf16x8 kf = *(const LAS bf16x8*)(lds + NA_K + sl * 8192 + cm * 128 + (((4 * ks + g) ^ ((cm >> 1) & 7)) * 16)); acc = MFMA32(kf, qf[ks], acc); }
#pragma unroll
                    for (int e = 0; e < 4; ++e) { const int cc = cs0 + 16 * ct + 4 * g + e; const bool valid = (cc >= csq) && (cc < csq + 16);
                        const int bi = (kr - r + 7) * 31 + min(max(cc - cq + 15, 0), 30);
                        const float sv = valid ? acc[e] + BI[bi] : -INFINITY; acc[e] = sv; mx = fmaxf(mx, sv); }
                    sT[rr][ct] = acc; } }
            mx = fmaxf(mx, __shfl_xor(mx, 16)); mx = fmaxf(mx, __shfl_xor(mx, 32));
            float lsum = 0.f;
#pragma unroll
            for (int rr = 0; rr < 4; ++rr)
#pragma unroll
                for (int ct = 0; ct < 2; ++ct)
#pragma unroll
                    for (int e = 0; e < 4; ++e) { const float p = __expf(sT[rr][ct][e] - mx); sT[rr][ct][e] = p; lsum += p; }
            lsum += __shfl_xor(lsum, 16); lsum += __shfl_xor(lsum, 32);
            f32x4 O[4];
#pragma unroll
            for (int mt = 0; mt < 4; ++mt) O[mt] = (f32x4){0.f, 0.f, 0.f, 0.f};
#pragma unroll
            for (int rr = 0; rr < 4; ++rr) { const int sl = (rs + 4 * kh + rr) & 7;
                const u32x4 pw = (u32x4){pk2(sT[rr][0][0], sT[rr][0][1]), pk2(sT[rr][0][2], sT[rr][0][3]), pk2(sT[rr][1][0], sT[rr][1][1]), pk2(sT[rr][1][2], sT[rr][1][3])};
                const bf16x8 pb = __builtin_bit_cast(bf16x8, pw);
#pragma unroll
                for (int mt = 0; mt < 4; ++mt) { const int dd = 16 * mt + l15, sw = 2 * ((dd >> 1) & 7);
                    const LAS unsigned char* vb = lds + NA_V + sl * 8192 + dd * 128;
                    const u32x2 lo = *(const LAS u32x2*)(vb + ((((cs0 >> 2) + g) ^ sw) * 8)), hi = *(const LAS u32x2*)(vb + ((((cs0 >> 2) + 4 + g) ^ sw) * 8));
                    const u32x4 vv = (u32x4){lo.x, lo.y, hi.x, hi.y};
                    O[mt] = MFMA32(__builtin_bit_cast(bf16x8, vv), pb, O[mt]); } }
            LAS float* MG = (LAS float*)(lds + NA_MRG + qg * 4608) + lane;
            if (kh == 1) { MG[0] = mx; MG[64] = lsum;
#pragma unroll
                for (int mt = 0; mt < 4; ++mt)
#pragma unroll
                    for (int e = 0; e < 4; ++e) MG[(2 + mt * 4 + e) * 64] = O[mt][e]; }
            __syncthreads();
            if (kh == 0) { const float m1 = MG[0], l1 = MG[64], M = fmaxf(mx, m1), a0 = __expf(mx - M), a1 = __expf(m1 - M), inv = 1.0f / (lsum * a0 + l1 * a1);
                bf16* op = nao + (rowb + (size_t)r * 64 + cq) * DM + h * 64 + 4 * g;
#pragma unroll
                for (int mt = 0; mt < 4; ++mt) { float v[4];
#pragma unroll
                    for (int e = 0; e < 4; ++e) v[e] = (O[mt][e] * a0 + MG[(2 + mt * 4 + e) * 64] * a1) * inv;
                    u32x2 w; w.x = pk2(v[0], v[1]); w.y = pk2(v[2], v[3]); *(u32x2*)(op + 16 * mt) = w; } }
            if (need_new) NA_STOREROW(rs + 8, kreg, vreg);
            if (more) { qf[0] = qn[0]; qf[1] = qn[1]; }
            __syncthreads();
        }
#undef NA_RS
#undef NA_LOADROW
#undef NA_STOREROW
#undef NA_LOADQ
    }
    __syncthreads();
}

#define XB_TMO      128
#define XB_XCNT(j)  (256  + 64 * (j))
#define XB_XSUB(j)  (1280 + 64 * (j))
#define XB_XGEN(j)  (2304 + 64 * (j))
#define XB_TOP      3328
#define XB_TOPGEN   3392
#define XCD_BAR_WORDS 3456
#define XB_SPIN_CAP (1u << 18)

__device__ __forceinline__ unsigned xb_ld(unsigned* p)              { return __hip_atomic_load(p, __ATOMIC_RELAXED, __HIP_MEMORY_SCOPE_AGENT); }
__device__ __forceinline__ unsigned xb_add(unsigned* p, unsigned v) { return __hip_atomic_fetch_add(p, v, __ATOMIC_RELAXED, __HIP_MEMORY_SCOPE_AGENT); }
__device__ __forceinline__ unsigned xb_xcc_id() { return (unsigned)__builtin_amdgcn_s_getreg((3 << 11) | 20) & 0xFu; }
#define XB_SPIN(cond, bar) do { unsigned _sp = 0; while (cond) { __builtin_amdgcn_s_sleep(1); \
    if ((++_sp & 255u) == 0u) { if (xb_ld(&(bar)[XB_TMO])) break; if (_sp > XB_SPIN_CAP) { atomicAdd(&(bar)[XB_TMO], 1u); break; } } } } while (0)

struct XcdBarrier {
    unsigned* bar; unsigned x;
    volatile LAS unsigned* st;
};

__device__ __forceinline__ XcdBarrier xcd_barrier_post(unsigned* bar, volatile LAS unsigned* st) {
    XcdBarrier b; b.bar = bar; b.x = xb_xcc_id(); b.st = st;
    if (threadIdx.x == 0) (void)xb_add(&bar[XB_XCNT(b.x)], 1u);
    return b;
}
__device__ __forceinline__ void xcd_barrier_complete(unsigned* bar, unsigned x, unsigned& nloc, unsigned& nx) {
    const unsigned G = gridDim.x * gridDim.y * gridDim.z;
    unsigned sum, cnt, mine, sp = 0u;
    for (;;) {
        sum = 0u; cnt = 0u; mine = 0u;
#pragma unroll
        for (unsigned j = 0; j < 16; ++j) { const unsigned c = xb_ld(&bar[XB_XCNT(j)]); sum += c; cnt += (c > 0u) ? 1u : 0u; mine = (j == x) ? c : mine; }
        if (sum == G) break;
        __builtin_amdgcn_s_sleep(1);
        if ((++sp & 255u) == 0u) { if (xb_ld(&bar[XB_TMO])) break; if (sp > XB_SPIN_CAP) { atomicAdd(&bar[XB_TMO], 1u); break; } }
    }
    nloc = mine > 0u ? mine : 1u; nx = cnt > 0u ? cnt : 1u;
}

__device__ __forceinline__ void xcd_barrier(const XcdBarrier& b) {
    asm volatile("s_waitcnt vmcnt(0)" ::: "memory");
    __syncthreads();
    if (threadIdx.x == 0) {
        unsigned* bar = b.bar;
        __builtin_amdgcn_s_waitcnt(0);
        unsigned nloc = b.st[0], nx = b.st[1];
        if (nloc == 0u) { xcd_barrier_complete(bar, b.x, nloc, nx); b.st[0] = nloc; b.st[1] = nx; }
        const unsigned old = xb_add(&bar[XB_XSUB(b.x)], 1u);
        const unsigned gen = old / nloc;
        if (old + 1u == (gen + 1u) * nloc) {
            __builtin_amdgcn_fence(__ATOMIC_RELEASE, "agent");
            asm volatile("s_waitcnt vmcnt(0)" ::: "memory");
            const unsigned og = xb_add(&bar[XB_TOP], 1u);
            const unsigned tg = og / nx;
            if (og + 1u == (tg + 1u) * nx) xb_add(&bar[XB_TOPGEN], 1u);
            else XB_SPIN(xb_ld(&bar[XB_TOPGEN]) == tg, bar);
            __builtin_amdgcn_fence(__ATOMIC_ACQUIRE, "agent");
            xb_add(&bar[XB_XGEN(b.x)], 1u);
            asm volatile("s_waitcnt vmcnt(0)" ::: "memory");
        } else {
            XB_SPIN(xb_ld(&bar[XB_XGEN(b.x)]) == gen, bar);
            __builtin_amdgcn_fence(__ATOMIC_ACQUIRE, "agent");
            asm volatile("s_waitcnt vmcnt(0)" ::: "memory");
        }
    }
    __syncthreads();
}

constexpr int N_PHASES = 15;
__global__ void __launch_bounds__(NTHR, 2) fwd_kernel(Args A) {
    extern __shared__ __attribute__((aligned(16))) unsigned char lds_raw[];
    LAS unsigned char* lds = (LAS unsigned char*)lds_raw;
    const int tid = threadIdx.x, lane = tid & 63, wave = __builtin_amdgcn_readfirstlane(tid >> 6);
    const int G = gridDim.x, bx = blockIdx.x;
    unsigned char* ws = A.ws;
#define Wt_in ((bf16*)(ws + WS_WIN))
#define Wt_na ((bf16*)(ws + WS_WNA))
#define Wt_gla ((bf16*)(ws + WS_WGLA))
#define Wt_out ((bf16*)(ws + WS_WOUT))
#define Wt_up ((bf16*)(ws + WS_WUP))
#define Wt_down ((bf16*)(ws + WS_WDOWN))
#define biasp ((float*)(ws + WS_BIAS))
#define U ((bf16*)(ws + WS_U))
#define NAO ((bf16*)(ws + WS_NAO))
#define GLAO ((bf16*)(ws + WS_NAO) + 512)
#define HB ((bf16*)(ws + WS_NAO))
#define PROJ ((bf16*)(ws + WS_PROJ))
#define HDN ((bf16*)(ws + WS_PROJ))
#define ctl ((unsigned*)(ws + WS_CTL))
    const int gw = bx * NWAVES + wave, NGW = G * NWAVES;
    const int lo = A.ph_lo, hi = A.ph_hi;
#ifndef PH_MASK
#define PH_MASK 0x1ff
#endif
#define PHM(b) ((PH_MASK >> (b)) & 1)
#define IN(k) (lo <= (k) && (k) < hi)
    if (tid < 2) ((volatile LAS unsigned*)(lds + LDS_BYTES - 64))[tid] = 0u;
    __syncthreads();
    XcdBarrier xbar; xbar.bar = ctl + 4096; xbar.x = 0; xbar.st = nullptr;
    if (A.coop) xbar = xcd_barrier_post(ctl + 4096, (volatile LAS unsigned*)(lds + LDS_BYTES - 64));
#define SEAM(k) do { if (IN(k) && IN((k) + 1)) { if ((k) == 0) cg::this_grid().sync(); else xcd_barrier(xbar); } } while (0)

    if (PHM(0) && IN(0)) {
        LAS float* scr = (LAS float*)(lds + wave * 16384);
        constexpr int I_IN = (DM / 64) * (5152 / 32), I_BR = (512 / 64) * (DM / 32), I_OUT = (DM / 64) * (DM / 32), I_UP = (DM / 64) * (DFF / 32), I_DN = (DFF / 64) * (DM / 32);
        constexpr int NITEMS = I_IN + 2 * I_BR + I_OUT + I_UP + I_DN;
        for (int pass = 0; pass < 2; ++pass) {
        if ((pass ^ (wave & 1)) == 0) {
        for (int it = gw; it < NITEMS; it += NGW) {
            int r = it;
            if (r < I_IN) { transpose_item<1>(A.w_in, DM, 5152, Wt_in, scr, r, lane, nullptr); continue; } r -= I_IN;
            if (r < I_BR) { transpose_item<0>(A.w_br_na, 512, DM, Wt_na, scr, r, lane, nullptr, DM, 0); continue; } r -= I_BR;
            if (r < I_BR) { transpose_item<0>(A.w_br_gla, 512, DM, Wt_na, scr, r, lane, nullptr, DM, 512); continue; } r -= I_BR;
            if (r < I_OUT) { transpose_item<0>(A.w_out, DM, DM, Wt_out, scr, r, lane, nullptr); continue; } r -= I_OUT;
            if (r < I_UP) { transpose_item<2>(A.w_up, DM, DFF, Wt_up, scr, r, lane, A.norm_mlp_g); continue; } r -= I_UP;
            transpose_item<3>(A.w_down, DFF, DM, Wt_down, scr, r, lane, nullptr);
        }
        } else {
        for (int m = gw; m < SBTOK; m += NGW) rms_row2_to_bf16(A.x[0] + (size_t)m * DM, A.x[1] + (size_t)m * DM, A.norm_mix_g, U + (size_t)m * DM, (bf16*)(A.out + (size_t)SBTOK * DM) + (size_t)m * DM, lane);
        }
        }
        {   const int gt = bx * NTHR + tid, NGT = G * NTHR;
            u32x4* zp = (u32x4*)(Wt_in + (size_t)5152 * DM);
            for (int i = gt; i < 224 * DM * 2 / 16; i += NGT) zp[i] = (u32x4){0u, 0u, 0u, 0u};
            for (int n = gt; n < NP; n += NGT) { float v = 0.f; if (n < 3072) v = A.b_in[n]; else if (n < C_LR) v = A.b_in[n + 32]; else if (n < C_LR + 32) v = A.b_in[3072 + (n - C_LR)]; biasp[n] = v; } }
        __syncthreads();
    }
    SEAM(0);

#pragma unroll 1
    for (int sb = 0; sb < 2; ++sb) {
        const int P = 1 + 7 * sb;
        const int T = sb ? 4096 : 2048, nB = sb ? 16 : 32;
        const float* xsb = A.x[sb]; float* outsb = A.out + (size_t)sb * SBTOK * DM;
        float* ssq1 = (float*)(ws + WS_SSQ1) + sb * SBTOK; float* ssq2 = (float*)(ws + WS_SSQ2) + sb * SBTOK;
        if (PHM(1) && IN(P)) { pg8::Gemm g{sb ? (const bf16*)outsb : (const bf16*)U, Wt_in, SBTOK, NP, DM}; pg8::StaticOrder S; S.init(SBTOK, NP, G, bx);
            pg8::EpiProj E{PROJ, biasp};
            pg8::gemm_phase<pg8::EpiProj, pg8::StaticOrder, true, true>(lds, g, S, E); }
        SEAM(P);
        bf16* QS = (bf16*)(ws + WS_U); bf16* HT = (bf16*)(ws + WS_U + 64 * MiB); float* DD = (float*)(ws + WS_U + 96 * MiB);
        const int nseg = T / GSEG, ngla = nB * 4 * nseg;
        if (IN(P + 1)) {
            const bool na_first = ((bx >> 3) & 1) != 0;
            if (PHM(3) && na_first) na_phase(lds, A, PROJ, NAO, T, nB, ctl + 64 * (1 + sb), tid);
            if (PHM(2)) for (int item = bx; item < ngla; item += G) gla_pass1(lds, A, PROJ, (bf16*)outsb, QS, HT, DD, T, item / (4 * nseg), (item / nseg) & 3, item % nseg, tid);
            if (PHM(3) && !na_first) na_phase(lds, A, PROJ, NAO, T, nB, ctl + 64 * (1 + sb), tid);
        }
        SEAM(P + 1);
        if (IN(P + 2)) {
            if (PHM(2)) for (int item = bx; item < ngla; item += G) gla_pass2(lds, A, PROJ, (const bf16*)outsb, QS, HT, DD, GLAO, T, item / (4 * nseg), (item / nseg) & 3, item % nseg, tid);
        }
        SEAM(P + 2);
        if (PHM(4) && IN(P + 3)) { pg8::Gemm g{NAO, Wt_na, SBTOK, DM, DM}; pg8::StaticOrder S; S.init(SBTOK, DM, G, bx); pg8::EpiBranchFused E{PROJ, U};
            pg8::gemm_phase<pg8::EpiBranchFused, pg8::StaticOrder, true, true>(lds, g, S, E); }
        SEAM(P + 3);
        if (PHM(5) && IN(P + 4)) { pg8::Gemm g{U, Wt_out, SBTOK, DM, DM}; pg8::StaticOrder S; S.init(SBTOK, DM, G, bx);
            pg8::EpiOut E{xsb, HB, ssq1};
            pg8::gemm_phase<pg8::EpiOut, pg8::StaticOrder, true, true>(lds, g, S, E); }
        SEAM(P + 4);
        if (PHM(6) && IN(P + 5)) { pg8::Gemm g{HB, Wt_up, SBTOK, DFF, DM}; pg8::StaticOrder S; S.init(SBTOK, DFF, G, bx);
            pg8::EpiUp E{ssq1, HDN};
            pg8::gemm_phase<pg8::EpiUp, pg8::StaticOrder, true, true>(lds, g, S, E); }
        SEAM(P + 5);
        if (PHM(7) && IN(P + 6)) { pg8::Gemm g{HDN, Wt_down, SBTOK, DM, DFF}; pg8::StaticOrder S; S.init(SBTOK, DM, G, bx);
            pg8::EpiDownNorm E{HB, outsb, ssq2, ctl + 1024 + sb * 256, A.norm_final_g};
            pg8::gemm_phase<pg8::EpiDownNorm, pg8::StaticOrder, true, true, true>(lds, g, S, E); }
        if (sb == 0) SEAM(P + 6);
    }
#undef IN
#undef SEAM
}

extern "C" void kernel_launch(void* const* d_in, const int* in_sizes, int n_in, void* d_out, int out_size, void* d_ws, size_t ws_size, hipStream_t stream) {
    static int grid = 0;
    if (grid == 0) {
        if (n_in != 18 || ws_size < WS_END) { fprintf(stderr, "kernel_launch: unexpected n_in %d / ws_size %zu\n", n_in, ws_size); grid = -1; return; }
        int dev = 0, cus = 0, per_cu = 0;
        hipGetDevice(&dev); hipDeviceGetAttribute(&cus, hipDeviceAttributeMultiprocessorCount, dev);
        if (hipFuncSetAttribute((const void*)fwd_kernel, hipFuncAttributeMaxDynamicSharedMemorySize, LDS_BYTES) != hipSuccess) { fprintf(stderr, "kernel_launch: hipFuncSetAttribute failed\n"); grid = -1; return; }
        if (hipOccupancyMaxActiveBlocksPerMultiprocessor(&per_cu, (const void*)fwd_kernel, NTHR, LDS_BYTES) != hipSuccess || per_cu < 1) { fprintf(stderr, "kernel_launch: occupancy query says %d\n", per_cu); per_cu = 1; }
        (void)hipGetLastError();
        grid = cus * per_cu;
    }
    if (grid < 0) return;
    hipMemsetAsync((char*)d_ws + WS_CTL, 0, CTL_BYTES, stream);
    Args a{};
    a.x[0] = (const float*)d_in[0]; a.x[1] = (const float*)d_in[1]; a.norm_mix_g = (const float*)d_in[2]; a.w_in = (const float*)d_in[3]; a.b_in = (const float*)d_in[4];
    a.na_rpb = (const float*)d_in[5]; a.gk_w[0] = (const float*)d_in[6]; a.gk_b[0] = (const float*)d_in[7]; a.gk_w[1] = (const float*)d_in[8]; a.gk_b[1] = (const float*)d_in[9];
    a.gla_norm_g = (const float*)d_in[10]; a.w_br_na = (const float*)d_in[11]; a.w_br_gla = (const float*)d_in[12]; a.w_out = (const float*)d_in[13];
    a.norm_mlp_g = (const float*)d_in[14]; a.w_up = (const float*)d_in[15]; a.w_down = (const float*)d_in[16]; a.norm_final_g = (const float*)d_in[17];
    a.out = (float*)d_out; a.ws = (unsigned char*)d_ws;
#if MK_SINGLE
    a.ph_lo = 0; a.ph_hi = N_PHASES; a.coop = 1;
    void* args[] = {&a};
    hipError_t e = hipLaunchCooperativeKernel((const void*)fwd_kernel, dim3(grid), dim3(NTHR), args, LDS_BYTES, stream);
    if (e != hipSuccess) fprintf(stderr, "cooperative launch failed: %s (grid %d)\n", hipGetErrorString(e), grid);
#else
    for (int p = 0; p < N_PHASES; ++p) { a.ph_lo = p; a.ph_hi = p + 1; a.coop = 0;
        hipLaunchKernelGGL(fwd_kernel, dim3(grid), dim3(NTHR), LDS_BYTES, stream, a); }
#endif
}
```

```cpp
#include <hip/hip_runtime.h>
#include <hip/hip_cooperative_groups.h>
#include <cstdio>
#include <cstdint>
namespace cg = cooperative_groups;

#ifndef MK_SINGLE
#define MK_SINGLE 1
#endif

constexpr int DM = 1024, DFF = 4096, NP = 5376  , SBTOK = 65536;
constexpr int C_NAQ = 0, C_NAK = 512, C_NAV = 1024, C_GQ = 1536, C_GK = 1792, C_GV = 2048, C_GG = 2560, C_SNA = 3072, C_SGLA = 4096, C_LR = 5120;
constexpr float RMS_EPS = 1e-6f;
namespace pg8 {
#define PG8_LAS __attribute__((address_space(3)))
typedef unsigned short bf16_t;
typedef short bf16x8 __attribute__((ext_vector_type(8)));
typedef float f32x4 __attribute__((ext_vector_type(4)));
typedef unsigned u32x4 __attribute__((ext_vector_type(4)));
constexpr int BM = 256, BK = 64, HALF = 128, HTB = HALF * BK * 2  , STAGE_BYTES = 8 * HTB, NXCD = 8, WGM = 8;

__host__ __device__ __forceinline__ int lds_byte(int r, int c) { const int st = (r >> 4) * 2 + (c >> 5), rr = r & 15, cc = c & 31, ob = rr * 64 + cc * 2; return st * 1024 + (ob ^ (((ob >> 9) & 1) << 5)); }
__host__ __device__ __forceinline__ void stage_rc(int b, int& R, int& C) { const int st = b / 1024, sb = b % 1024, swz = sb ^ (((sb >> 9) & 1) << 5); R = (st >> 1) * 16 + swz / 64; C = (st & 1) * 32 + (swz % 64) / 2; }
__host__ __device__ __forceinline__ int perm32(int rho) { const int n = rho >> 4, i = rho & 15; return 8 * (i >> 2) + 4 * n + (i & 3); }

struct Unit { int pm, pn; };
struct Gemm { const bf16_t* A; const bf16_t* Bt; int M, N, K; };

struct StaticOrder {
    int nM, nN, nwg, G, c;
    __host__ __device__ void init(int M, int N, int G_, int c_) { nM = M / BM; nN = N / BM; nwg = nM * nN; G = G_; c = c_; }
    __host__ __device__ bool next(int i, Unit& u) const {
        const long L = (long)i * G + c; if (L >= nwg) return false;
        int wgid = (int)L; { const int q = nwg / NXCD, r = nwg % NXCD, xcd = wgid % NXCD, off = wgid / NXCD; wgid = (xcd < r ? xcd * (q + 1) : r * (q + 1) + (xcd - r) * q) + off; }
        const int nig = WGM * nN, gid = wgid / nig, fm = gid * WGM, gsz = (nM - fm) < WGM ? (nM - fm) : WGM;
        u.pm = fm + ((wgid % nig) % gsz); u.pn = (wgid % nig) / gsz; return true;
    }
    __device__ __forceinline__ void a_ready(const Unit&) const {}
    __device__ __forceinline__ void done(const Unit&) const {}
};

__device__ __forceinline__ unsigned cvt_pk_bf16(float lo, float hi) { unsigned r; asm volatile("v_cvt_pk_bf16_f32 %0, %1, %2" : "=v"(r) : "v"(lo), "v"(hi)); return r; }
typedef unsigned u32x2 __attribute__((ext_vector_type(2)));
__device__ __forceinline__ float bf2f(unsigned short b) { return __uint_as_float((unsigned)b << 16); }
__device__ __forceinline__ float sigmoidf_(float x) { return __builtin_amdgcn_rcpf(1.0f + __builtin_amdgcn_exp2f(-1.4426950408889634f * x)); }

struct EpiProj {
    static constexpr bool PERM = true, AFTER_DRAIN = false, MID = false;
    bf16_t* O; const float* bias;
    __device__ __forceinline__ void operator()(const f32x4 (&acc)[2][2][4][2], const Unit& u, int wr, int wc, int fr, int fq) const {
        const int row0 = u.pm * BM + wr * 64 + fr, pn = u.pn;
        const int mode = (pn < 2 || pn == 6) ? 1 : ((pn == 10 || pn == 11) ? 2 : ((pn >= 12 && pn < 20) ? 3 : 0));
        const int col0 = pn * BM + wc * 32 + 8 * fq;
        f32x4 bv[2][2];
#pragma unroll
        for (int bj = 0; bj < 2; ++bj)
#pragma unroll
            for (int n = 0; n < 2; ++n) bv[bj][n] = *(const f32x4*)(bias + col0 + bj * HALF + 4 * n);
#pragma unroll
        for (int ai = 0; ai < 2; ++ai)
#pragma unroll
            for (int m = 0; m < 4; ++m) { bf16_t* rowp = O + (size_t)(row0 + ai * HALF + m * 16) * NP + col0;
#pragma unroll
                for (int bj = 0; bj < 2; ++bj) { f32x4 v0 = acc[ai][bj][m][0] + bv[bj][0], v1 = acc[ai][bj][m][1] + bv[bj][1];
                    if (mode == 1) { v0 = v0 * 0.125f; v1 = v1 * 0.125f; }
                    else if (mode == 2) {
#pragma unroll
                        for (int e = 0; e < 4; ++e) { v0[e] = v0[e] * sigmoidf_(v0[e]); v1[e] = v1[e] * sigmoidf_(v1[e]); } }
                    else if (mode == 3) {
#pragma unroll
                        for (int e = 0; e < 4; ++e) { v0[e] = sigmoidf_(v0[e]); v1[e] = sigmoidf_(v1[e]); } }
                    u32x4 w; w.x = cvt_pk_bf16(v0[0], v0[1]); w.y = cvt_pk_bf16(v0[2], v0[3]); w.z = cvt_pk_bf16(v1[0], v1[1]); w.w = cvt_pk_bf16(v1[2], v1[3]);
                    *(u32x4*)(rowp + bj * HALF) = w; } }
    }
};

template <bool ADD> struct EpiBranch {
    static constexpr bool PERM = true, AFTER_DRAIN = false, MID = false;
    const bf16_t* proj; int gcol; bf16_t* O;
    __device__ __forceinline__ void operator()(const f32x4 (&acc)[2][2][4][2], const Unit& u, int wr, int wc, int fr, int fq) const {
        const int row0 = u.pm * BM + wr * 64 + fr, col0 = u.pn * BM + wc * 32 + 8 * fq;
#pragma unroll
        for (int ai = 0; ai < 2; ++ai)
#pragma unroll
            for (int m = 0; m < 4; ++m) { const size_t r = (size_t)(row0 + ai * HALF + m * 16);
#pragma unroll
                for (int bj = 0; bj < 2; ++bj) {
                    const u32x4 gw = *(const u32x4*)(proj + r * NP + gcol + col0 + bj * HALF);
                    u32x4 pw = (u32x4){0u, 0u, 0u, 0u}; if (ADD) pw = *(const u32x4*)(O + r * DM + col0 + bj * HALF);
                    float o[8];
#pragma unroll
                    for (int e = 0; e < 8; ++e) { const unsigned g2 = gw[e >> 1], p2 = pw[e >> 1];
                        const float gt = (e & 1) ? __uint_as_float(g2 & 0xffff0000u) : __uint_as_float(g2 << 16);
                        const float pv = (e & 1) ? __uint_as_float(p2 & 0xffff0000u) : __uint_as_float(p2 << 16);
                        o[e] = pv + gt * acc[ai][bj][m][e >> 2][e & 3]; }
                    u32x4 w; w.x = cvt_pk_bf16(o[0], o[1]); w.y = cvt_pk_bf16(o[2], o[3]); w.z = cvt_pk_bf16(o[4], o[5]); w.w = cvt_pk_bf16(o[6], o[7]);
                    *(u32x4*)(O + r * DM + col0 + bj * HALF) = w; }
                asm volatile("" ::: "memory"); }
    }
};

struct EpiBranchFused {
    static constexpr bool PERM = true, AFTER_DRAIN = false, MID = true;
    const bf16_t* proj; bf16_t* O;
    __device__ __forceinline__ void mid(f32x4 (&acc)[2][2][4][2], const Unit& u, int wr, int wc, int fr_in, int fq_in) const {
        int fr = fr_in, fq = fq_in; asm volatile("" : "+v"(fr), "+v"(fq));
        const int row0 = u.pm * BM + wr * 64 + fr, col0 = u.pn * BM + wc * 32 + 8 * fq;
#pragma unroll
        for (int ai = 0; ai < 2; ++ai)
#pragma unroll
            for (int m = 0; m < 4; ++m) { const size_t r = (size_t)(row0 + ai * HALF + m * 16);
#pragma unroll
                for (int bj = 0; bj < 2; ++bj) {
                    const u32x4 ga = *(const u32x4*)(proj + r * NP + C_SNA + col0 + bj * HALF), gb = *(const u32x4*)(proj + r * NP + C_SGLA + col0 + bj * HALF);
#pragma unroll
                    for (int e = 0; e < 8; ++e) { const unsigned a2 = ga[e >> 1], b2 = gb[e >> 1];
                        const float sa = (e & 1) ? __uint_as_float(a2 & 0xffff0000u) : __uint_as_float(a2 << 16), sb = (e & 1) ? __uint_as_float(b2 & 0xffff0000u) : __uint_as_float(b2 << 16);
                        acc[ai][bj][m][e >> 2][e & 3] *= sa * __builtin_amdgcn_rcpf(sb); } }
                if (m == 3) asm volatile("" ::: "memory"); }
    }
    __device__ __forceinline__ void operator()(const f32x4 (&acc)[2][2][4][2], const Unit& u, int wr, int wc, int fr, int fq) const {
        const int row0 = u.pm * BM + wr * 64 + fr, col0 = u.pn * BM + wc * 32 + 8 * fq;
#pragma unroll
        for (int ai = 0; ai < 2; ++ai)
#pragma unroll
            for (int m = 0; m < 4; ++m) { const size_t r = (size_t)(row0 + ai * HALF + m * 16);
#pragma unroll
                for (int bj = 0; bj < 2; ++bj) {
                    const u32x4 gb = *(const u32x4*)(proj + r * NP + C_SGLA + col0 + bj * HALF);
                    float o[8];
#pragma unroll
                    for (int e = 0; e < 8; ++e) { const unsigned b2 = gb[e >> 1]; const float sb = (e & 1) ? __uint_as_float(b2 & 0xffff0000u) : __uint_as_float(b2 << 16);
                        o[e] = sb * acc[ai][bj][m][e >> 2][e & 3]; }
                    u32x4 w; w.x = cvt_pk_bf16(o[0], o[1]); w.y = cvt_pk_bf16(o[2], o[3]); w.z = cvt_pk_bf16(o[4], o[5]); w.w = cvt_pk_bf16(o[6], o[7]);
                    *(u32x4*)(O + r * DM + col0 + bj * HALF) = w; }
                if (m == 3) asm volatile("" ::: "memory"); }
    }
};

struct EpiOut {
    static constexpr bool PERM = false, AFTER_DRAIN = false, MID = false;
    const float* base; bf16_t* hb; float* ssq;
    __device__ __forceinline__ void operator()(const f32x4 (&acc)[2][2][4][2], const Unit& u, int wr, int wc, int fr, int fq) const {
        const int col0 = u.pn * BM + wc * 32 + 4 * fq;
#pragma unroll
        for (int ai = 0; ai < 2; ++ai) {
            f32x4 xv[4][2][2];
#pragma unroll
            for (int m = 0; m < 4; ++m) { const size_t r = (size_t)(u.pm * BM + ai * HALF + wr * 64 + m * 16 + fr);
#pragma unroll
                for (int bj = 0; bj < 2; ++bj)
#pragma unroll
                    for (int n = 0; n < 2; ++n) xv[m][bj][n] = *(const f32x4*)(base + r * DM + col0 + bj * HALF + n * 16); }
#pragma unroll
            for (int m = 0; m < 4; ++m) { const size_t r = (size_t)(u.pm * BM + ai * HALF + wr * 64 + m * 16 + fr); float s = 0.f;
#pragma unroll
                for (int bj = 0; bj < 2; ++bj)
#pragma unroll
                    for (int n = 0; n < 2; ++n) { const size_t off = r * DM + col0 + bj * HALF + n * 16;
                        const f32x4 h = xv[m][bj][n] + acc[ai][bj][m][n];
                        s += (h[0] * h[0] + h[1] * h[1]) + (h[2] * h[2] + h[3] * h[3]);
                        u32x2 w; w.x = cvt_pk_bf16(h[0], h[1]); w.y = cvt_pk_bf16(h[2], h[3]); *(u32x2*)(hb + off) = w; }
                s += __shfl_xor(s, 16); s += __shfl_xor(s, 32);
                if (fq == 0) atomicAdd(ssq + r, s); }
            asm volatile("" ::: "memory"); }
    }
};
struct EpiDownNorm {
    static constexpr bool PERM = false, AFTER_DRAIN = false, MID = false;
    const bf16_t* hb; float* out; float* ssq; unsigned* cnt; const float* gain;
    __device__ __forceinline__ void operator()(const f32x4 (&acc_)[2][2][4][2], const Unit& u, int wr, int wc, int fr, int fq) const {
        f32x4 (&acc)[2][2][4][2] = const_cast<f32x4 (&)[2][2][4][2]>(acc_);
        const int col0 = u.pn * BM + wc * 32 + 4 * fq;
#pragma unroll
        for (int ai = 0; ai < 2; ++ai) {
            u32x2 hv[4][2][2];
#pragma unroll
            for (int m = 0; m < 4; ++m) { const size_t r = (size_t)(u.pm * BM + ai * HALF + wr * 64 + m * 16 + fr);
#pragma unroll
                for (int bj = 0; bj < 2; ++bj)
#pragma unroll
                    for (int n = 0; n < 2; ++n) hv[m][bj][n] = *(const u32x2*)(hb + r * DM + col0 + bj * HALF + n * 16); }
#pragma unroll
            for (int m = 0; m < 4; ++m) { const size_t r = (size_t)(u.pm * BM + ai * HALF + wr * 64 + m * 16 + fr); float s = 0.f;
#pragma unroll
                for (int bj = 0; bj < 2; ++bj)
#pragma unroll
                    for (int n = 0; n < 2; ++n) { const u32x2 hw = hv[m][bj][n];
                        f32x4 h = acc[ai][bj][m][n];
                        h[0] += __uint_as_float(hw.x << 16); h[1] += __uint_as_float(hw.x & 0xffff0000u); h[2] += __uint_as_float(hw.y << 16); h[3] += __uint_as_float(hw.y & 0xffff0000u);
                        acc[ai][bj][m][n] = h; s += (h[0] * h[0] + h[1] * h[1]) + (h[2] * h[2] + h[3] * h[3]); }
                s += __shfl_xor(s, 16); s += __shfl_xor(s, 32);
                if (fq == 0) atomicAdd(ssq + r, s); }
            asm volatile("" ::: "memory"); }
        asm volatile("s_waitcnt vmcnt(0)" ::: "memory");
        if ((threadIdx.x & 63) == 0) __hip_atomic_fetch_add(cnt + u.pm, 1u, __ATOMIC_RELAXED, __HIP_MEMORY_SCOPE_AGENT);
        {   unsigned spins = 0;
            while ((unsigned)__builtin_amdgcn_readfirstlane((int)__hip_atomic_load(cnt + u.pm, __ATOMIC_RELAXED, __HIP_MEMORY_SCOPE_AGENT)) < 32u) { __builtin_amdgcn_s_sleep(2); if (++spins > (1u << 22)) break; } }
        asm volatile("" ::: "memory");
#pragma unroll
        for (int ai = 0; ai < 2; ++ai)
#pragma unroll
            for (int m = 0; m < 4; ++m) { const size_t r = (size_t)(u.pm * BM + ai * HALF + wr * 64 + m * 16 + fr);
                const float rstd = rsqrtf(__hip_atomic_load(ssq + r, __ATOMIC_RELAXED, __HIP_MEMORY_SCOPE_AGENT) * (1.0f / DM) + RMS_EPS);
#pragma unroll
                for (int bj = 0; bj < 2; ++bj)
#pragma unroll
                    for (int n = 0; n < 2; ++n) { const size_t off = r * DM + col0 + bj * HALF + n * 16; const f32x4 gg = *(const f32x4*)(gain + col0 + bj * HALF + n * 16);
                        *(f32x4*)(out + off) = acc[ai][bj][m][n] * rstd * gg; }
                asm volatile("" ::: "memory"); }
    }
};

struct EpiUp {
    static constexpr bool PERM = true, AFTER_DRAIN = false, MID = false;
    const float* ssq; bf16_t* O;
    __device__ __forceinline__ void operator()(const f32x4 (&acc)[2][2][4][2], const Unit& u, int wr, int wc, int fr, int fq) const {
        const int row0 = u.pm * BM + wr * 64 + fr, col0 = u.pn * BM + wc * 32 + 8 * fq;
#pragma unroll
        for (int ai = 0; ai < 2; ++ai)
#pragma unroll
            for (int m = 0; m < 4; ++m) { const size_t r = (size_t)(row0 + ai * HALF + m * 16);
                const float rstd = rsqrtf(ssq[r] * (1.0f / DM) + RMS_EPS);
#pragma unroll
                for (int bj = 0; bj < 2; ++bj) { f32x4 v0 = acc[ai][bj][m][0] * rstd, v1 = acc[ai][bj][m][1] * rstd;
#pragma unroll
                    for (int e = 0; e < 4; ++e) { const float a = fmaxf(v0[e], 0.f), b = fmaxf(v1[e], 0.f); v0[e] = a * a; v1[e] = b * b; }
                    u32x4 w; w.x = cvt_pk_bf16(v0[0], v0[1]); w.y = cvt_pk_bf16(v0[2], v0[3]); w.z = cvt_pk_bf16(v1[0], v1[1]); w.w = cvt_pk_bf16(v1[2], v1[3]);
                    const int col = col0 + bj * HALF;
                    *(u32x4*)(O + ((((r >> 8) * (DFF / 64) + (col >> 6)) * 256 + (r & 255)) * 64 + (col & 63))) = w; } }
    }
};

template <class Epi, class Sched, bool ALIGN_EPI = false, bool SP2 = false, bool TILED = false>
__device__ __forceinline__ void gemm_phase(PG8_LAS unsigned char* lds, const Gemm g, const Sched& S, const Epi& E) {
    int tid_ = threadIdx.x; asm volatile("" : "+v"(tid_));
    const int tid = tid_, wid = __builtin_amdgcn_readfirstlane(tid >> 6), lane = tid & 63, wr = wid >> 2, wc = wid & 3, fr = lane & 15, fq = lane >> 4;
    const int K = g.K, nt = K / BK;
    unsigned voffA[2], voffB[2];
#pragma unroll
    for (int i = 0; i < 2; ++i) { int R, C; stage_rc(tid * 16 + i * 8192, R, C); const int Rb = Epi::PERM ? ((R & ~31) + perm32(R & 31)) : R;
        const int rs = TILED ? BK : K; voffA[i] = (unsigned)(R * rs + C) * 2u; voffB[i] = (unsigned)(Rb * rs + C) * 2u; }
    const size_t kstep = TILED ? (size_t)(BM * BK * 2) : (size_t)(BK * 2);
    const size_t hstep = TILED ? (size_t)(HALF * BK * 2) : (size_t)HALF * K * 2;
    const size_t tstep = TILED ? (size_t)(K / BK) * (BM * BK * 2) : 2 * hstep;
    const unsigned ldsw = (unsigned)wid * 1024u;
    const int aoff = lds_byte(wr * 64 + fr, fq * 8), boff = lds_byte(wc * 32 + fr, fq * 8);
#define PG8_SA(b, h) (((b) * 2 + (h)) * HTB)
#define PG8_SB(b, h) ((4 + (b) * 2 + (h)) * HTB)
#define PG8_STAGE(bufoff, gbase, voff) do { _Pragma("unroll") for (int _i = 0; _i < 2; ++_i) \
        __builtin_amdgcn_global_load_lds((const unsigned*)((const char*)(gbase) + (voff)[_i]), (PG8_LAS unsigned*)(lds + (bufoff) + ldsw + _i * 8192), 16, 0, 0); } while (0)
#define PG8_LDA(dst, b, h) do { _Pragma("unroll") for (int m = 0; m < 4; ++m) _Pragma("unroll") for (int k = 0; k < 2; ++k) dst[m][k] = *(const PG8_LAS bf16x8*)(lds + PG8_SA(b, h) + aoff + m * 2048 + k * 1024); } while (0)
#define PG8_LDB(dst, b, h) do { _Pragma("unroll") for (int n = 0; n < 2; ++n) _Pragma("unroll") for (int k = 0; k < 2; ++k) dst[n][k] = *(const PG8_LAS bf16x8*)(lds + PG8_SB(b, h) + boff + n * 2048 + k * 1024); } while (0)
#define PG8_MMA(ai, bj, At, Bt) do { __builtin_amdgcn_s_setprio(1); _Pragma("unroll") for (int m = 0; m < 4; ++m) _Pragma("unroll") for (int n = 0; n < 2; ++n) _Pragma("unroll") for (int k = 0; k < 2; ++k) \
        acc[ai][bj][m][n] = __builtin_amdgcn_mfma_f32_16x16x32_bf16(Bt[n][k], At[m][k], acc[ai][bj][m][n], 0, 0, 0); __builtin_amdgcn_s_setprio(0); } while (0)
#define PG8_WAIT_V(n) asm volatile("s_waitcnt vmcnt(" #n ")" ::: "memory")
#define PG8_WAIT_L(n) asm volatile("s_waitcnt lgkmcnt(" #n ")" ::: "memory")
#define PG8_BAR __builtin_amdgcn_s_barrier()
#define PG8_SCHED __builtin_amdgcn_sched_barrier(0)
    Unit cur, nxt; int ui = 0;
    if (!S.next(0, cur)) return;
    f32x4 acc[2][2][4][2];
#pragma unroll
    for (int a = 0; a < 2; ++a)
#pragma unroll
        for (int b = 0; b < 2; ++b)
#pragma unroll
            for (int m = 0; m < 4; ++m)
#pragma unroll
                for (int n = 0; n < 2; ++n) acc[a][b][m][n] = (f32x4){0.f, 0.f, 0.f, 0.f};
    bf16x8 At[4][2], B0[2][2], B1[2][2];
    const char* cA = (const char*)g.A + (size_t)cur.pm * tstep; const char* cB = (const char*)g.Bt + (size_t)cur.pn * tstep;
    S.a_ready(cur);
    if constexpr (SP2) {
        PG8_STAGE(PG8_SB(0, 0), cB, voffB); PG8_STAGE(PG8_SB(0, 1), cB + hstep, voffB); PG8_STAGE(PG8_SA(0, 0), cA, voffA); PG8_STAGE(PG8_SA(0, 1), cA + hstep, voffA);
        if (wr == 1) PG8_BAR;
        PG8_WAIT_V(2); PG8_BAR;
        PG8_STAGE(PG8_SB(1, 0), cB + kstep, voffB); PG8_STAGE(PG8_SA(1, 0), cA + kstep, voffA); PG8_STAGE(PG8_SB(1, 1), cB + hstep + kstep, voffB);
        PG8_WAIT_V(6); PG8_BAR;
    } else {
        PG8_STAGE(PG8_SB(0, 0), cB, voffB); PG8_STAGE(PG8_SA(0, 0), cA, voffA); PG8_STAGE(PG8_SB(0, 1), cB + hstep, voffB); PG8_STAGE(PG8_SA(0, 1), cA + hstep, voffA);
        if (wr == 1) PG8_BAR;
        PG8_WAIT_V(4); PG8_BAR;
        PG8_STAGE(PG8_SB(1, 0), cB + kstep, voffB); PG8_STAGE(PG8_SA(1, 0), cA + kstep, voffA); PG8_STAGE(PG8_SB(1, 1), cB + hstep + kstep, voffB);
        PG8_WAIT_V(6); PG8_BAR;
    }
    for (;;) {
        const bool has_next = S.next(ui + 1, nxt);
        const char* nA = has_next ? (const char*)g.A + (size_t)nxt.pm * tstep : cA; const char* nB = has_next ? (const char*)g.Bt + (size_t)nxt.pn * tstep : cB;
        for (int t = 0; t < nt; t += 2) {
            const bool last = (t == nt - 2);
            const char* a1 = cA + (size_t)(t + 1) * kstep;
            const char* a2 = last ? nA : cA + (size_t)(t + 2) * kstep; const char* b2 = last ? nB : cB + (size_t)(t + 2) * kstep;
            const char* a3 = a2 + kstep; const char* b3 = b2 + kstep;
            if (last && has_next) S.a_ready(nxt);
            if constexpr (Epi::MID) { if (t == nt / 2) E.mid(acc, cur, wr, wc, fr, fq); }
            if constexpr (SP2) {
            PG8_LDB(B0, 0, 0); PG8_LDB(B1, 0, 1); PG8_SCHED; PG8_LDA(At, 0, 0); PG8_STAGE(PG8_SA(1, 1), a1 + hstep, voffA);
            PG8_WAIT_V(8); PG8_WAIT_L(0); PG8_BAR; PG8_MMA(0, 0, At, B0); PG8_MMA(0, 1, At, B1); PG8_BAR; PG8_SCHED;
            PG8_LDA(At, 0, 1); PG8_STAGE(PG8_SB(0, 0), b2, voffB); PG8_STAGE(PG8_SB(0, 1), b2 + hstep, voffB); PG8_STAGE(PG8_SA(0, 0), a2, voffA);
            PG8_WAIT_V(8); PG8_WAIT_L(0); PG8_BAR; PG8_MMA(1, 0, At, B0); PG8_MMA(1, 1, At, B1); PG8_BAR; PG8_SCHED;
            PG8_LDB(B0, 1, 0); PG8_LDB(B1, 1, 1); PG8_SCHED; PG8_LDA(At, 1, 0); PG8_STAGE(PG8_SA(0, 1), a2 + hstep, voffA);
            PG8_WAIT_V(8); PG8_WAIT_L(0); PG8_BAR; PG8_MMA(0, 0, At, B0); PG8_MMA(0, 1, At, B1); PG8_BAR; PG8_SCHED;
            PG8_LDA(At, 1, 1); PG8_STAGE(PG8_SB(1, 0), b3, voffB); PG8_STAGE(PG8_SB(1, 1), b3 + hstep, voffB); PG8_STAGE(PG8_SA(1, 0), a3, voffA);
            PG8_WAIT_V(8); PG8_WAIT_L(0); PG8_BAR; PG8_MMA(1, 0, At, B0); PG8_MMA(1, 1, At, B1); PG8_BAR; PG8_SCHED;
            } else {
            PG8_LDB(B0, 0, 0); PG8_SCHED; PG8_LDA(At, 0, 0); PG8_STAGE(PG8_SA(1, 1), a1 + hstep, voffA);
            PG8_WAIT_L(8); PG8_BAR; PG8_WAIT_L(0); PG8_MMA(0, 0, At, B0); PG8_BAR; PG8_SCHED;
            PG8_LDB(B1, 0, 1); PG8_STAGE(PG8_SB(0, 0), b2, voffB);
            PG8_BAR; PG8_WAIT_L(0); PG8_MMA(0, 1, At, B1); PG8_BAR;
            PG8_LDA(At, 0, 1); PG8_STAGE(PG8_SA(0, 0), a2, voffA);
            PG8_BAR; PG8_WAIT_L(0); PG8_MMA(1, 0, At, B0); PG8_BAR; PG8_SCHED;
            PG8_STAGE(PG8_SB(0, 1), b2 + hstep, voffB);
            PG8_WAIT_V(6); PG8_BAR; PG8_MMA(1, 1, At, B1); PG8_BAR;
            PG8_LDB(B0, 1, 0); PG8_SCHED; PG8_LDA(At, 1, 0); PG8_STAGE(PG8_SA(0, 1), a2 + hstep, voffA);
            PG8_WAIT_L(8); PG8_BAR; PG8_WAIT_L(0); PG8_MMA(0, 0, At, B0); PG8_BAR; PG8_SCHED;
            PG8_LDB(B1, 1, 1); PG8_STAGE(PG8_SB(1, 0), b3, voffB);
            PG8_BAR; PG8_WAIT_L(0); PG8_MMA(0, 1, At, B1); PG8_BAR;
            PG8_LDA(At, 1, 1); PG8_STAGE(PG8_SA(1, 0), a3, voffA);
            PG8_BAR; PG8_WAIT_L(0); PG8_MMA(1, 0, At, B0); PG8_BAR; PG8_SCHED;
            PG8_STAGE(PG8_SB(1, 1), b3 + hstep, voffB);
            PG8_WAIT_V(6); PG8_BAR; PG8_MMA(1, 1, At, B1); PG8_BAR;
            }
        }
        if constexpr (ALIGN_EPI) { if (wr == 0) PG8_BAR; }
        if constexpr (!Epi::AFTER_DRAIN) { E(acc, cur, wr, wc, fr, fq); S.done(cur); }
        if (!has_next) break;
#pragma unroll
        for (int a = 0; a < 2; ++a)
#pragma unroll
            for (int b = 0; b < 2; ++b)
#pragma unroll
                for (int m = 0; m < 4; ++m)
#pragma unroll
                    for (int n = 0; n < 2; ++n) acc[a][b][m][n] = (f32x4){0.f, 0.f, 0.f, 0.f};
        cur = nxt; cA = nA; cB = nB; ++ui;
        if constexpr (ALIGN_EPI) { if (wr == 1) PG8_BAR; }
    }
    PG8_WAIT_V(0);
    if constexpr (!ALIGN_EPI) { if (wr == 0) PG8_BAR; }
    PG8_BAR;
    if constexpr (Epi::AFTER_DRAIN) { E.fused(acc, cur, wr, wc, fr, fq, lds, wid, lane); S.done(cur); }
#undef PG8_SA
#undef PG8_SB
#undef PG8_STAGE
#undef PG8_LDA
#undef PG8_LDB
#undef PG8_MMA
#undef PG8_WAIT_V
#undef PG8_WAIT_L
#undef PG8_BAR
#undef PG8_SCHED
}
}

#define LAS __attribute__((address_space(3)))
#define DI __device__ __forceinline__
typedef unsigned short bf16;
typedef short bf16x8 __attribute__((ext_vector_type(8)));
typedef short s16x4 __attribute__((ext_vector_type(4)));
typedef float f32x4 __attribute__((ext_vector_type(4)));
typedef float f32x2 __attribute__((ext_vector_type(2)));
typedef unsigned u32x4 __attribute__((ext_vector_type(4)));
typedef unsigned u32x2 __attribute__((ext_vector_type(2)));
typedef __bf16 bf16v2 __attribute__((ext_vector_type(2)));
constexpr int NWAVES = 8, NTHR = 512;
constexpr int LDS_BYTES = 155648;

constexpr size_t MiB = 1u << 20;
constexpr size_t WS_CTL = 0, CTL_BYTES = 2 * MiB;
constexpr size_t WS_SSQ1 = 512 * 1024, WS_SSQ2 = 1024 * 1024;
constexpr size_t WS_WIN = 2 * MiB, WS_WNA = 13 * MiB, WS_WGLA = 14 * MiB, WS_WOUT = 15 * MiB, WS_WUP = 17 * MiB, WS_WDOWN = 25 * MiB, WS_BIAS = 33 * MiB;
constexpr size_t WS_U = 34 * MiB;
constexpr size_t WS_NAO = 162 * MiB, WS_GLAO = 226 * MiB;
constexpr size_t WS_PROJ = 290 * MiB;
constexpr size_t WS_END = 962 * MiB;

DI float bf2f(unsigned short b) { return __uint_as_float((unsigned)b << 16); }
DI unsigned pk2(float lo, float hi) { f32x2 v = {lo, hi}; bf16v2 b = __builtin_convertvector(v, bf16v2); return __builtin_bit_cast(unsigned, b); }
DI unsigned short f2bf(float x) { return (unsigned short)(pk2(x, 0.f) & 0xffffu); }
DI float wave_sum(float v) {
#pragma unroll
    for (int o = 1; o < 64; o <<= 1) v += __shfl_xor(v, o);
    return v;
}
#define LDS_WAIT() asm volatile("s_waitcnt lgkmcnt(0)" ::: "memory")
#define BAR_LDS() do { asm volatile("s_waitcnt lgkmcnt(0)" ::: "memory"); __builtin_amdgcn_s_barrier(); asm volatile("" ::: "memory"); } while (0)
#define MFMA32(a, b, c) __builtin_amdgcn_mfma_f32_16x16x32_bf16((a), (b), (c), 0, 0, 0)
#define MFMA16(a, b, c) __builtin_amdgcn_mfma_f32_16x16x16bf16_1k((a), (b), (c), 0, 0, 0)

struct Args {
    const float* x[2]; const float* norm_mix_g; const float* w_in; const float* b_in; const float* na_rpb;
    const float* gk_w[2]; const float* gk_b[2]; const float* gla_norm_g; const float* w_br_na; const float* w_br_gla; const float* w_out;
    const float* norm_mlp_g; const float* w_up; const float* w_down; const float* norm_final_g;
    float* out; unsigned char* ws; int ph_lo, ph_hi, coop, pad;
};

template <int MODE>
DI void transpose_item(const float* W, int K, int N, bf16* WT, LAS float* scr, int item, int lane, const float* g, int ldk = 0, int koff = 0) {
    if (ldk == 0) ldk = K;
    const int nblk = N / 32, kb = item / nblk, nb = item % nblk, k0 = 64 * kb, n0 = 32 * nb;
#pragma unroll 8
    for (int i = 0; i < 32; ++i) { const int kk = 2 * i + (lane >> 5); float v = W[(size_t)(k0 + kk) * N + n0 + (lane & 31)]; if (MODE == 2) v *= g[k0 + kk]; scr[kk * 33 + (lane & 31)] = v; }
    LDS_WAIT();
    int d0 = n0; if (MODE == 1) d0 = (n0 < 3072) ? n0 : ((n0 < 3104) ? (C_LR + (n0 - 3072)) : (n0 - 32));
    const int c = lane & 7;
#pragma unroll
    for (int j = 0; j < 4; ++j) { const int n = (lane >> 3) + 8 * j; const LAS float* s = scr + (8 * c) * 33 + n;
        u32x4 o; o.x = pk2(s[0 * 33], s[1 * 33]); o.y = pk2(s[2 * 33], s[3 * 33]); o.z = pk2(s[4 * 33], s[5 * 33]); o.w = pk2(s[6 * 33], s[7 * 33]);
        if (MODE == 3) *(u32x4*)(WT + ((((size_t)((d0 + n) >> 8) * (K / 64) + (k0 >> 6)) * 256 + ((d0 + n) & 255)) * 64 + 8 * c)) = o;
        else *(u32x4*)(WT + (size_t)(d0 + n) * ldk + koff + k0 + 8 * c) = o; }
    LDS_WAIT();
}
DI void rms_row2_to_bf16(const float* xrow0, const float* xrow1, const float* g, bf16* orow0, bf16* orow1, int lane) {
    const f32x4* xr0 = (const f32x4*)xrow0 + lane; const f32x4* xr1 = (const f32x4*)xrow1 + lane; const f32x4* gr = (const f32x4*)g + lane;
    f32x4 v0[4], v1[4]; float s0 = 0.f, s1 = 0.f;
#pragma unroll
    for (int j = 0; j < 4; ++j) { v0[j] = __builtin_nontemporal_load(xr0 + 64 * j); v1[j] = __builtin_nontemporal_load(xr1 + 64 * j); }
#pragma unroll
    for (int j = 0; j < 4; ++j) { s0 += (v0[j].x * v0[j].x + v0[j].y * v0[j].y) + (v0[j].z * v0[j].z + v0[j].w * v0[j].w); s1 += (v1[j].x * v1[j].x + v1[j].y * v1[j].y) + (v1[j].z * v1[j].z + v1[j].w * v1[j].w); }
    const float r0 = rsqrtf(wave_sum(s0) * (1.f / DM) + RMS_EPS), r1 = rsqrtf(wave_sum(s1) * (1.f / DM) + RMS_EPS);
    u32x2* o0 = (u32x2*)orow0 + lane; u32x2* o1 = (u32x2*)orow1 + lane;
#pragma unroll
    for (int j = 0; j < 4; ++j) { const f32x4 gg = gr[64 * j]; u32x2 w;
        w.x = pk2(v0[j].x * r0 * gg.x, v0[j].y * r0 * gg.y); w.y = pk2(v0[j].z * r0 * gg.z, v0[j].w * r0 * gg.w); o0[64 * j] = w;
        w.x = pk2(v1[j].x * r1 * gg.x, v1[j].y * r1 * gg.y); w.y = pk2(v1[j].z * r1 * gg.z, v1[j].w * r1 * gg.w); o1[64 * j] = w; }
}
DI void rms_row_to_bf16(const float* xrow, const float* g, bf16* orow, int lane) {
    const f32x4* xr = (const f32x4*)xrow + lane; const f32x4* gr = (const f32x4*)g + lane;
    f32x4 v[4]; float s = 0.f;
#pragma unroll
    for (int j = 0; j < 4; ++j) { v[j] = xr[64 * j]; s += (v[j].x * v[j].x + v[j].y * v[j].y) + (v[j].z * v[j].z + v[j].w * v[j].w); }
    const float rstd = rsqrtf(wave_sum(s) * (1.f / DM) + RMS_EPS);
    u32x2* o8 = (u32x2*)orow + lane;
#pragma unroll
    for (int j = 0; j < 4; ++j) { const f32x4 gg = gr[64 * j]; u32x2 w; w.x = pk2(v[j].x * rstd * gg.x, v[j].y * rstd * gg.y); w.y = pk2(v[j].z * rstd * gg.z, v[j].w * rstd * gg.w); o8[64 * j] = w; }
}
DI void final_row(float* row, const float* g, float ssq, int lane) {
    f32x4* xr = (f32x4*)row + lane; const f32x4* gr = (const f32x4*)g + lane;
    const float rstd = rsqrtf(ssq * (1.f / DM) + RMS_EPS);
#pragma unroll
    for (int j = 0; j < 4; ++j) { f32x4 v = xr[64 * j]; const f32x4 gg = gr[64 * j]; v = v * rstd; v = v * gg; xr[64 * j] = v; }
}

constexpr int GL_P = 144;
constexpr int GL_QD = 0, GL_KI = 9216, GL_KDT = 18432, GL_VT = 27648, GL_DEC = 46080, GL_LR = 47104, GL_CL = 51200, GL_OB = 52224, GL_OBP = 272, GL_DIR = 52224 + 64 * 272;
constexpr int GSEG = 1024;
DI float fexp_(float x) { return __builtin_amdgcn_exp2f(1.4426950408889634f * x); }
DI float logsigmoid_(float x) { return fminf(x, 0.f) - 0.6931471805599453f * __builtin_amdgcn_logf(1.0f + fexp_(-fabsf(x))); }

DI void gla_pass1(LAS unsigned char* lds, const Args& A, const bf16* proj, bf16* scratch, bf16* QS, bf16* HT, float* DD, int T, int b, int h, int k, int tid_in) {
    int tid = tid_in; asm volatile("" : "+v"(tid));
    const int lane = tid & 63, wave = tid >> 6, dir = wave >> 2, c = wave & 3, d = lane, g = lane >> 4, l15 = lane & 15;
    LAS unsigned char* L = lds + dir * GL_DIR;
    constexpr int NI = GSEG / 64;
    const size_t rowb = (size_t)b * T + (size_t)k * GSEG;
    const int sidx = ((b * 4 + h) * (T / GSEG) + k) * 2 + dir;
    unsigned gkp[8];
#pragma unroll
    for (int j = 0; j < 8; ++j) gkp[j] = pk2(A.gk_w[dir][(2 * j) * 256 + h * 64 + d], A.gk_w[dir][(2 * j + 1) * 256 + h * 64 + d]);
    const float gkb = A.gk_b[dir][h * 64 + d];
    f32x4 S[4][2];
#pragma unroll
    for (int mt = 0; mt < 4; ++mt)
#pragma unroll
        for (int nt = 0; nt < 2; ++nt) S[mt][nt] = (f32x4){0.f, 0.f, 0.f, 0.f};
    const int vs = c * 32;
    const int tl = tid & 255;
    float carry = 0.f;
    unsigned short qraw[16], kraw[16]; u32x2 lrraw; u32x4 vraw[4];
#define GLA_ROW(s) (rowb + (size_t)(dir ? (GSEG - 1 - (s)) : (s)))
#define GLA_PREFETCH(it) do { const int s0_ = (it) * 64; \
        _Pragma("unroll") for (int i = 0; i < 16; ++i) { const bf16* p_ = proj + GLA_ROW(s0_ + c * 16 + i) * NP + h * 64 + d; qraw[i] = p_[C_GQ]; kraw[i] = p_[C_GK]; } \
        lrraw = *(const u32x2*)(proj + GLA_ROW(s0_ + c * 16 + (lane >> 2)) * NP + C_LR + dir * 16 + (lane & 3) * 4); \
        _Pragma("unroll") for (int q = 0; q < 4; ++q) { const int idx_ = tl + 256 * q; vraw[q] = *(const u32x4*)(proj + GLA_ROW(s0_ + (idx_ & 63)) * NP + C_GV + h * 128 + (idx_ >> 6) * 8); } } while (0)
#define GLA_FLUSH(itf) do { _Pragma("unroll") for (int q_ = 0; q_ < 4; ++q_) { const int idx_ = tl + 256 * q_, tk_ = idx_ >> 4, ch_ = idx_ & 15; \
        *(u32x4*)(scratch + GLA_ROW((itf) * 64 + tk_) * DM + dir * 512 + h * 128 + ch_ * 8) = *(const LAS u32x4*)(L + GL_OB + tk_ * GL_OBP + ch_ * 16); } } while (0)
    GLA_PREFETCH(0);
#pragma unroll 1
    for (int it = 0; it < NI; ++it) {
        BAR_LDS();
        if (it > 0) GLA_FLUSH(it - 1);
        *(LAS u32x2*)(L + GL_LR + (c * 16 + (lane >> 2)) * 32 + (lane & 3) * 8) = lrraw;
        LDS_WAIT();
        float qdv[16];
        {   float cum = 0.f; float kinv[16];
#pragma unroll
            for (int i = 0; i < 16; ++i) {
                const LAS u32x4* lr4 = (const LAS u32x4*)(L + GL_LR + (c * 16 + i) * 32);
                const u32x4 la_ = lr4[0], lb_ = lr4[1];
                const unsigned lw[8] = {la_.x, la_.y, la_.z, la_.w, lb_.x, lb_.y, lb_.z, lb_.w};
                float pre = gkb;
#pragma unroll
                for (int j = 0; j < 8; ++j) pre = __builtin_amdgcn_fdot2_f32_bf16(__builtin_bit_cast(bf16v2, lw[j]), __builtin_bit_cast(bf16v2, gkp[j]), pre, false);
                cum += logsigmoid_(pre) * (1.0f / 16.0f);
                const float e = fexp_(cum); qdv[i] = bf2f(qraw[i]) * e;
                kinv[i] = bf2f(kraw[i]) * __builtin_amdgcn_rcpf(e);
                *(LAS unsigned short*)(L + GL_QD + (c * 16 + i) * GL_P + d * 2) = f2bf(qdv[i]);
                *(LAS unsigned short*)(L + GL_KI + (c * 16 + i) * GL_P + d * 2) = f2bf(kinv[i]);
            }
            const float eL = fexp_(cum);
            ((LAS float*)(L + GL_DEC))[c * 64 + d] = eL;
            ((LAS float*)(L + GL_CL))[c * 64 + d] = cum;
            u32x4 w0, w1;
            w0.x = pk2(kinv[0] * eL, kinv[1] * eL); w0.y = pk2(kinv[2] * eL, kinv[3] * eL); w0.z = pk2(kinv[4] * eL, kinv[5] * eL); w0.w = pk2(kinv[6] * eL, kinv[7] * eL);
            w1.x = pk2(kinv[8] * eL, kinv[9] * eL); w1.y = pk2(kinv[10] * eL, kinv[11] * eL); w1.z = pk2(kinv[12] * eL, kinv[13] * eL); w1.w = pk2(kinv[14] * eL, kinv[15] * eL);
            *(LAS u32x4*)(L + GL_KDT + d * GL_P + c * 32) = w0; *(LAS u32x4*)(L + GL_KDT + d * GL_P + c * 32 + 16) = w1;
        }
#pragma unroll
        for (int q = 0; q < 4; ++q) { const int idx = tl + 256 * q, tk = idx & 63, v0 = (idx >> 6) * 8;
#pragma unroll
            for (int e = 0; e < 8; ++e) { const unsigned w = vraw[q][e >> 1]; *(LAS unsigned short*)(L + GL_VT + (v0 + e) * GL_P + tk * 2) = (unsigned short)((e & 1) ? (w >> 16) : (w & 0xffffu)); } }
        BAR_LDS();
        {   const LAS float* CL = (const LAS float*)(L + GL_CL) + d; const float c0 = CL[0], c1 = CL[64], c2 = CL[128], c3 = CL[192];
            const float off = carry + ((c > 0) ? c0 : 0.f) + ((c > 1) ? c1 : 0.f) + ((c > 2) ? c2 : 0.f);
            carry += (c0 + c1) + (c2 + c3);
            const float eo = fexp_(off);
#pragma unroll
            for (int i = 0; i < 16; ++i) QS[GLA_ROW(it * 64 + c * 16 + i) * 512 + dir * 256 + h * 64 + d] = f2bf(qdv[i] * eo); }
#pragma unroll
        for (int cc = 0; cc < 4; ++cc) {
            const int trow = cc * 16 + l15;
            f32x4 X = (f32x4){0.f, 0.f, 0.f, 0.f};
#pragma unroll
            for (int ks = 0; ks < 2; ++ks) { const bf16x8 ki = *(const LAS bf16x8*)(L + GL_KI + trow * GL_P + (ks * 32 + 8 * g) * 2), qd = *(const LAS bf16x8*)(L + GL_QD + trow * GL_P + (ks * 32 + 8 * g) * 2);
                X = MFMA32(ki, qd, X); }
#pragma unroll
            for (int r = 0; r < 4; ++r) if (4 * g + r > l15) X[r] = 0.f;
            u32x2 pp; pp.x = pk2(X[0], X[1]); pp.y = pk2(X[2], X[3]);
            const s16x4 P = __builtin_bit_cast(s16x4, pp);
            s16x4 vt[2]; f32x4 o[2];
#pragma unroll
            for (int nt = 0; nt < 2; ++nt) { vt[nt] = *(const LAS s16x4*)(L + GL_VT + (vs + 16 * nt + l15) * GL_P + (cc * 16 + 4 * g) * 2);
                o[nt] = MFMA16(P, vt[nt], ((f32x4){0.f, 0.f, 0.f, 0.f})); }
#pragma unroll
            for (int ks = 0; ks < 2; ++ks) {
                const u32x2 qlo = *(const LAS u32x2*)(L + GL_QD + trow * GL_P + (32 * ks + 4 * g) * 2), qhi = *(const LAS u32x2*)(L + GL_QD + trow * GL_P + (32 * ks + 16 + 4 * g) * 2);
                const u32x4 qq = (u32x4){qlo.x, qlo.y, qhi.x, qhi.y}; const bf16x8 qa = __builtin_bit_cast(bf16x8, qq);
#pragma unroll
                for (int nt = 0; nt < 2; ++nt) { const f32x4 s0 = S[2 * ks][nt], s1 = S[2 * ks + 1][nt];
                    const u32x4 sw = (u32x4){pk2(s0[0], s0[1]), pk2(s0[2], s0[3]), pk2(s1[0], s1[1]), pk2(s1[2], s1[3])};
                    o[nt] = MFMA32(qa, __builtin_bit_cast(bf16x8, sw), o[nt]); } }
#pragma unroll
            for (int r = 0; r < 4; ++r) { LAS unsigned short* op = (LAS unsigned short*)(L + GL_OB + (cc * 16 + 4 * g + r) * GL_OBP + (vs + l15) * 2); op[0] = f2bf(o[0][r]); op[16] = f2bf(o[1][r]); }
#pragma unroll
            for (int mt = 0; mt < 4; ++mt) { const f32x4 dec = *(const LAS f32x4*)(L + GL_DEC + (cc * 64 + 16 * mt + 4 * g) * 4);
                const s16x4 kd = *(const LAS s16x4*)(L + GL_KDT + (16 * mt + l15) * GL_P + (cc * 16 + 4 * g) * 2);
#pragma unroll
                for (int nt = 0; nt < 2; ++nt) { f32x4 sv = S[mt][nt]; sv = sv * dec; S[mt][nt] = MFMA16(kd, vt[nt], sv); } }
            if (cc == 1 && it + 1 < NI) GLA_PREFETCH(it + 1);
        }
    }
    BAR_LDS();
    GLA_FLUSH(NI - 1);
#undef GLA_FLUSH
#undef GLA_PREFETCH
#undef GLA_ROW
#pragma unroll
    for (int mt = 0; mt < 4; ++mt)
#pragma unroll
        for (int nt = 0; nt < 2; ++nt) { u32x2 w; w.x = pk2(S[mt][nt][0], S[mt][nt][1]); w.y = pk2(S[mt][nt][2], S[mt][nt][3]);
            *(u32x2*)(HT + ((size_t)sidx * 128 + vs + 16 * nt + l15) * 64 + 16 * mt + 4 * g) = w; }
    if (c == 0) DD[(size_t)sidx * 64 + d] = fexp_(carry);
    __syncthreads();
}

constexpr int G2_S0 = 0, G2_OT = 36864, G2_OTP = 132;
DI void gla_pass2(LAS unsigned char* lds, const Args& A, const bf16* proj, const bf16* scratch, const bf16* QS, const bf16* HT, const float* DD, bf16* glao, int T, int b, int h, int k, int tid_in) {
    int tid = tid_in; asm volatile("" : "+v"(tid));
    const int lane = tid & 63, wave = tid >> 6, g = lane >> 4, l15 = lane & 15;
    const int nseg = T / GSEG;
    const size_t rowb = (size_t)b * T + (size_t)k * GSEG;
    const int ntk = tid >> 3, nvc = tid & 7;
    bf16x8 AF[4][2][2]; u32x4 SC[2][2]; u32x4 gw[2];
#define G2_LOAD(grp) do { _Pragma("unroll") for (int mt_ = 0; mt_ < 4; ++mt_) { const size_t r0_ = rowb + (grp) * 64 + mt_ * 16; \
        _Pragma("unroll") for (int dir_ = 0; dir_ < 2; ++dir_) _Pragma("unroll") for (int ks_ = 0; ks_ < 2; ++ks_) AF[mt_][dir_][ks_] = *(const bf16x8*)(QS + (r0_ + l15) * 512 + dir_ * 256 + h * 64 + ks_ * 32 + 8 * g); \
        } \
        { const u32x4* gp_ = (const u32x4*)(proj + (rowb + (grp) * 64 + ntk) * NP + C_GG + h * 128 + nvc * 16); gw[0] = gp_[0]; gw[1] = gp_[1]; \
          const u32x4* sp_ = (const u32x4*)(scratch + (rowb + (grp) * 64 + ntk) * DM + h * 128 + nvc * 16); SC[0][0] = sp_[0]; SC[0][1] = sp_[1]; SC[1][0] = sp_[64]; SC[1][1] = sp_[65]; } } while (0)
    G2_LOAD(0);
    {   const int dir = tid >> 8, oct = tid & 7, vq = (tid & 255) >> 3;
        float acc[4][8], w[8];
#pragma unroll
        for (int e = 0; e < 8; ++e) { w[e] = 1.f;
#pragma unroll
            for (int j = 0; j < 4; ++j) acc[j][e] = 0.f; }
        const int nsteps = dir ? (nseg - 1 - k) : k;
        const int sbase = ((b * 4 + h) * nseg) * 2 + dir, mstep = dir ? 2 : -2;
        int si = sbase + 2 * (dir ? (k + 1) : (k - 1));
        u32x4 hc[4]; f32x4 dc[2];
#define G2_LDH(sidx, hh, dd) do { _Pragma("unroll") for (int j_ = 0; j_ < 4; ++j_) hh[j_] = *(const u32x4*)(HT + ((size_t)(sidx) * 128 + vq + 32 * j_) * 64 + oct * 8); \
        dd[0] = *(const f32x4*)(DD + (size_t)(sidx) * 64 + oct * 8); dd[1] = *(const f32x4*)(DD + (size_t)(sidx) * 64 + oct * 8 + 4); } while (0)
        if (nsteps > 0) G2_LDH(si, hc, dc);
#pragma unroll 1
        for (int st = 0; st < nsteps; ++st) {
            u32x4 hn[4]; f32x4 dn[2];
#pragma unroll
            for (int j = 0; j < 4; ++j) hn[j] = hc[j];
            dn[0] = dc[0]; dn[1] = dc[1];
            si += mstep;
            if (st + 1 < nsteps) G2_LDH(si, hn, dn);
#pragma unroll
            for (int j = 0; j < 4; ++j)
#pragma unroll
                for (int e = 0; e < 8; ++e) { const unsigned x = hc[j][e >> 1]; const float hv = (e & 1) ? __uint_as_float(x & 0xffff0000u) : __uint_as_float(x << 16); acc[j][e] += w[e] * hv; }
#pragma unroll
            for (int e = 0; e < 8; ++e) w[e] *= (e < 4) ? dc[0][e & 3] : dc[1][e & 3];
#pragma unroll
            for (int j = 0; j < 4; ++j) hc[j] = hn[j];
            dc[0] = dn[0]; dc[1] = dn[1];
        }
#undef G2_LDH
#pragma unroll
        for (int j = 0; j < 4; ++j) *(LAS u32x4*)(lds + G2_S0 + dir * 18432 + (vq + 32 * j) * GL_P + oct * 16) =
            (u32x4){pk2(acc[j][0], acc[j][1]), pk2(acc[j][2], acc[j][3]), pk2(acc[j][4], acc[j][5]), pk2(acc[j][6], acc[j][7])};
    }
    BAR_LDS();
    bf16x8 Bf[2][2];
#pragma unroll
    for (int dir = 0; dir < 2; ++dir)
#pragma unroll
        for (int ks = 0; ks < 2; ++ks) Bf[dir][ks] = *(const LAS bf16x8*)(lds + G2_S0 + dir * 18432 + (16 * wave + l15) * GL_P + (ks * 32 + 8 * g) * 2);
    LAS float* OT = (LAS float*)(lds + G2_OT);
    f32x4 gn[4];
#pragma unroll
    for (int j = 0; j < 4; ++j) gn[j] = *(const f32x4*)(A.gla_norm_g + nvc * 16 + 4 * j);
#pragma unroll 1
    for (int grp = 0; grp < GSEG / 64; ++grp) {
#pragma unroll
        for (int mtile = 0; mtile < 4; ++mtile) {
            f32x4 acc = (f32x4){0.f, 0.f, 0.f, 0.f};
#pragma unroll
            for (int dir = 0; dir < 2; ++dir)
#pragma unroll
                for (int ks = 0; ks < 2; ++ks) acc = MFMA32(AF[mtile][dir][ks], Bf[dir][ks], acc);
#pragma unroll
            for (int r = 0; r < 4; ++r) OT[(mtile * 16 + 4 * g + r) * G2_OTP + 16 * wave + l15] = acc[r];
        }
        const u32x4 gw0 = gw[0], gw1 = gw[1], sf0 = SC[0][0], sf1 = SC[0][1], sb0 = SC[1][0], sb1 = SC[1][1];
        if (grp + 1 < GSEG / 64) G2_LOAD(grp + 1);
        BAR_LDS();
        {   const size_t row = rowb + grp * 64 + ntk; f32x4 sv[4]; float ss = 0.f;
#pragma unroll
            for (int j = 0; j < 4; ++j) { const u32x4 cf = (j < 2) ? sf0 : sf1, cb = (j < 2) ? sb0 : sb1; const unsigned f0 = cf[2 * (j & 1)], f1 = cf[2 * (j & 1) + 1], b0 = cb[2 * (j & 1)], b1 = cb[2 * (j & 1) + 1];
                f32x4 lo; lo.x = __uint_as_float(f0 << 16) + __uint_as_float(b0 << 16); lo.y = __uint_as_float(f0 & 0xffff0000u) + __uint_as_float(b0 & 0xffff0000u);
                lo.z = __uint_as_float(f1 << 16) + __uint_as_float(b1 << 16); lo.w = __uint_as_float(f1 & 0xffff0000u) + __uint_as_float(b1 & 0xffff0000u);
                sv[j] = *(const LAS f32x4*)(OT + ntk * G2_OTP + nvc * 16 + 4 * j) + lo; ss += (sv[j].x * sv[j].x + sv[j].y * sv[j].y) + (sv[j].z * sv[j].z + sv[j].w * sv[j].w); }
            ss += __shfl_xor(ss, 1); ss += __shfl_xor(ss, 2); ss += __shfl_xor(ss, 4);
            const float rstd = rsqrtf(ss * (1.0f / 128.0f) + RMS_EPS);
            u32x4* op = (u32x4*)(glao + row * DM + h * 128 + nvc * 16);
#pragma unroll
            for (int j2 = 0; j2 < 2; ++j2) { const u32x4 gq = j2 ? gw1 : gw0; const f32x4 a = sv[2 * j2] * rstd * gn[2 * j2], bb = sv[2 * j2 + 1] * rstd * gn[2 * j2 + 1];
                u32x4 w;
                w.x = pk2(a.x * __uint_as_float(gq.x << 16), a.y * __uint_as_float(gq.x & 0xffff0000u)); w.y = pk2(a.z * __uint_as_float(gq.y << 16), a.w * __uint_as_float(gq.y & 0xffff0000u));
                w.z = pk2(bb.x * __uint_as_float(gq.z << 16), bb.y * __uint_as_float(gq.z & 0xffff0000u)); w.w = pk2(bb.z * __uint_as_float(gq.w << 16), bb.w * __uint_as_float(gq.w & 0xffff0000u));
                op[j2] = w; }
        }
        BAR_LDS();
    }
#undef G2_LOAD
}

constexpr int NA_K = 0, NA_V = 65536, NA_MRG = 131072, NA_BIAS = 131072 + 18432, NA_ITEM = NA_BIAS + 1920;
static_assert(NA_ITEM + 64 <= LDS_BYTES, "NA LDS map");
DI void na_phase(LAS unsigned char* lds, const Args& A, const bf16* proj, bf16* nao, int T, int nB, unsigned* counter, int tid_in) {
    int tid = tid_in; asm volatile("" : "+v"(tid));
    const int lane = tid & 63, wave = tid >> 6, qg = wave & 3, kh = wave >> 2, g = lane >> 4, l15 = lane & 15;
    constexpr int NAR = 32;
    const int rows = T / 64, nr = rows / NAR, nitems = nB * 8 * nr;
    const int cq = 16 * qg + l15;
    const int cs0 = (qg == 0) ? 0 : ((qg == 1) ? 8 : ((qg == 2) ? 24 : 32));
    const int csq = min(max(cq - 8, 0), 48);
    const int lc = tid >> 3, lc8 = tid & 7;
    for (int item = (int)blockIdx.x; item < nitems; item += (int)gridDim.x) {
        __syncthreads();
        const int b = item / (8 * nr), h = (item / nr) & 7, r0 = (item % nr) * NAR;
        const size_t rowb = (size_t)b * T;
        if (tid < 465) ((LAS float*)(lds + NA_BIAS))[tid] = A.na_rpb[h * 465 + tid];
#define NA_RS(r) min(max((r) - 4, 0), rows - 8)
#define NA_LOADROW(kr, kreg, vreg) do { const bf16* p_ = proj + (rowb + (size_t)(kr) * 64 + lc) * NP + h * 64 + lc8 * 8; kreg = *(const u32x4*)(p_ + C_NAK); vreg = *(const u32x4*)(p_ + C_NAV); } while (0)
#define NA_STOREROW(kr, kreg, vreg) do { const int sl_ = (kr) & 7; \
            *(LAS u32x4*)(lds + NA_K + sl_ * 8192 + lc * 128 + ((lc8 ^ ((lc >> 1) & 7)) * 16)) = kreg; \
            _Pragma("unroll") for (int e = 0; e < 8; ++e) { const int d_ = lc8 * 8 + e; const unsigned w_ = vreg[e >> 1]; \
                *(LAS unsigned short*)(lds + NA_V + sl_ * 8192 + d_ * 128 + (((lc >> 2) ^ (2 * ((d_ >> 1) & 7))) * 8) + (lc & 3) * 2) = (unsigned short)((e & 1) ? (w_ >> 16) : (w_ & 0xffffu)); } } while (0)
        {   const int rs0 = NA_RS(r0); u32x4 kr8[8], vr8[8];
#pragma unroll
            for (int i = 0; i < 8; ++i) NA_LOADROW(rs0 + i, kr8[i], vr8[i]);
#pragma unroll
            for (int i = 0; i < 8; ++i) NA_STOREROW(rs0 + i, kr8[i], vr8[i]); }
        bf16x8 qf[2], qn[2];
#define NA_LOADQ(r, dst) do { const bf16* p_ = proj + (rowb + (size_t)(r) * 64 + cq) * NP + C_NAQ + h * 64 + 8 * g; dst[0] = *(const bf16x8*)p_; dst[1] = *(const bf16x8*)(p_ + 32); } while (0)
        NA_LOADQ(r0, qf);
        __syncthreads();
#pragma unroll 1
        for (int r = r0; r < r0 + NAR; ++r) {
            const int rs = NA_RS(r);
            const bool more = (r + 1 < r0 + NAR), need_new = more && (NA_RS(r + 1) != rs);
            u32x4 kreg = (u32x4){0u, 0u, 0u, 0u}, vreg = (u32x4){0u, 0u, 0u, 0u};
            if (need_new) NA_LOADROW(rs + 8, kreg, vreg);
            if (more) NA_LOADQ(r + 1, qn);
            f32x4 sT[4][2]; float mx = -INFINITY;
            const LAS float* BI = (const LAS float*)(lds + NA_BIAS);
#pragma unroll
            for (int rr = 0; rr < 4; ++rr) { const int kr = rs + 4 * kh + rr, sl = kr & 7;
#pragma unroll
                for (int ct = 0; ct < 2; ++ct) { const int cm = cs0 + 16 * ct + l15; f32x4 acc = (f32x4){0.f, 0.f, 0.f, 0.f};
#pragma unroll
                    for (int ks = 0; ks < 2; ++ks) { const bf16x8 kf = *(const LAS bf16x8*)(lds + NA_K + sl * 8192 + cm * 128 + (((4 * ks + g) ^ ((cm >> 1) & 7)) * 16)); acc = MFMA32(kf, qf[ks], acc); }
#pragma unroll
                    for (int e = 0; e < 4; ++e) { const int cc = cs0 + 16 * ct + 4 * g + e; const bool valid = (cc >= csq) && (cc < csq + 16);
                        const int bi = (kr - r + 7) * 31 + min(max(cc - cq + 15, 0), 30);
                        const float sv = valid ? acc[e] + BI[bi] : -INFINITY; acc[e] = sv; mx = fmaxf(mx, sv); }
                    sT[rr][ct] = acc; } }
            mx = fmaxf(mx, __shfl_xor(mx, 16)); mx = fmaxf(mx, __shfl_xor(mx, 32));
            float lsum = 0.f;
#pragma unroll
            for (int rr = 0; rr < 4; ++rr)
#pragma unroll
                for (int ct = 0; ct < 2; ++ct)
#pragma unroll
                    for (int e = 0; e < 4; ++e) { const float p = __expf(sT[rr][ct][e] - mx); sT[rr][ct][e] = p; lsum += p; }
            lsum += __shfl_xor(lsum, 16); lsum += __shfl_xor(lsum, 32);
            f32x4 O[4];
#pragma unroll
            for (int mt = 0; mt < 4; ++mt) O[mt] = (f32x4){0.f, 0.f, 0.f, 0.f};
#pragma unroll
            for (int rr = 0; rr < 4; ++rr) { const int sl = (rs + 4 * kh + rr) & 7;
                const u32x4 pw = (u32x4){pk2(sT[rr][0][0], sT[rr][0][1]), pk2(sT[rr][0][2], sT[rr][0][3]), pk2(sT[rr][1][0], sT[rr][1][1]), pk2(sT[rr][1][2], sT[rr][1][3])};
                const bf16x8 pb = __builtin_bit_cast(bf16x8, pw);
#pragma unroll
                for (int mt = 0; mt < 4; ++mt) { const int dd = 16 * mt + l15, sw = 2 * ((dd >> 1) & 7);
                    const LAS unsigned char* vb = lds + NA_V + sl * 8192 + dd * 128;
                    const u32x2 lo = *(const LAS u32x2*)(vb + ((((cs0 >> 2) + g) ^ sw) * 8)), hi = *(const LAS u32x2*)(vb + ((((cs0 >> 2) + 4 + g) ^ sw) * 8));
                    const u32x4 vv = (u32x4){lo.x, lo.y, hi.x, hi.y};
                    O[mt] = MFMA32(__builtin_bit_cast(bf16x8, vv), pb, O[mt]); } }
            LAS float* MG = (LAS float*)(lds + NA_MRG + qg * 4608) + lane;
            if (kh == 1) { MG[0] = mx; MG[64] = lsum;
#pragma unroll
                for (int mt = 0; mt < 4; ++mt)
#pragma unroll
                    for (int e = 0; e < 4; ++e) MG[(2 + mt * 4 + e) * 64] = O[mt][e]; }
            __syncthreads();
            if (kh == 0) { const float m1 = MG[0], l1 = MG[64], M = fmaxf(mx, m1), a0 = __expf(mx - M), a1 = __expf(m1 - M), inv = 1.0f / (lsum * a0 + l1 * a1);
                bf16* op = nao + (rowb + (size_t)r * 64 + cq) * DM + h * 64 + 4 * g;
#pragma unroll
                for (int mt = 0; mt < 4; ++mt) { float v[4];
#pragma unroll
                    for (int e = 0; e < 4; ++e) v[e] = (O[mt][e] * a0 + MG[(2 + mt * 4 + e) * 64] * a1) * inv;
                    u32x2 w; w.x = pk2(v[0], v[1]); w.y = pk2(v[2], v[3]); *(u32x2*)(op + 16 * mt) = w; } }
            if (need_new) NA_STOREROW(rs + 8, kreg, vreg);
            if (more) { qf[0] = qn[0]; qf[1] = qn[1]; }
            __syncthreads();
        }
#undef NA_RS
#undef NA_LOADROW
#undef NA_STOREROW
#undef NA_LOADQ
    }
    __syncthreads();
}

#define XB_TMO      128
#define XB_XCNT(j)  (256  + 64 * (j))
#define XB_XSUB(j)  (1280 + 64 * (j))
#define XB_XGEN(j)  (2304 + 64 * (j))
#define XB_TOP      3328
#define XB_TOPGEN   3392
#define XCD_BAR_WORDS 3456
#define XB_SPIN_CAP (1u << 18)

__device__ __forceinline__ unsigned xb_ld(unsigned* p)              { return __hip_atomic_load(p, __ATOMIC_RELAXED, __HIP_MEMORY_SCOPE_AGENT); }
__device__ __forceinline__ unsigned xb_add(unsigned* p, unsigned v) { return __hip_atomic_fetch_add(p, v, __ATOMIC_RELAXED, __HIP_MEMORY_SCOPE_AGENT); }
__device__ __forceinline__ unsigned xb_xcc_id() { return (unsigned)__builtin_amdgcn_s_getreg((3 << 11) | 20) & 0xFu; }
#define XB_SPIN(cond, bar) do { unsigned _sp = 0; while (cond) { __builtin_amdgcn_s_sleep(1); \
    if ((++_sp & 255u) == 0u) { if (xb_ld(&(bar)[XB_TMO])) break; if (_sp > XB_SPIN_CAP) { atomicAdd(&(bar)[XB_TMO], 1u); break; } } } } while (0)

struct XcdBarrier {
    unsigned* bar; unsigned x;
    volatile LAS unsigned* st;
};

__device__ __forceinline__ XcdBarrier xcd_barrier_post(unsigned* bar, volatile LAS unsigned* st) {
    XcdBarrier b; b.bar = bar; b.x = xb_xcc_id(); b.st = st;
    if (threadIdx.x == 0) (void)xb_add(&bar[XB_XCNT(b.x)], 1u);
    return b;
}
__device__ __forceinline__ void xcd_barrier_complete(unsigned* bar, unsigned x, unsigned& nloc, unsigned& nx) {
    const unsigned G = gridDim.x * gridDim.y * gridDim.z;
    unsigned sum, cnt, mine, sp = 0u;
    for (;;) {
        sum = 0u; cnt = 0u; mine = 0u;
#pragma unroll
        for (unsigned j = 0; j < 16; ++j) { const unsigned c = xb_ld(&bar[XB_XCNT(j)]); sum += c; cnt += (c > 0u) ? 1u : 0u; mine = (j == x) ? c : mine; }
        if (sum == G) break;
        __builtin_amdgcn_s_sleep(1);
        if ((++sp & 255u) == 0u) { if (xb_ld(&bar[XB_TMO])) break; if (sp > XB_SPIN_CAP) { atomicAdd(&bar[XB_TMO], 1u); break; } }
    }
    nloc = mine > 0u ? mine : 1u; nx = cnt > 0u ? cnt : 1u;
}

__device__ __forceinline__ void xcd_barrier(const XcdBarrier& b) {
    asm volatile("s_waitcnt vmcnt(0)" ::: "memory");
    __syncthreads();
    if (threadIdx.x == 0) {
        unsigned* bar = b.bar;
        __builtin_amdgcn_s_waitcnt(0);
        unsigned nloc = b.st[0], nx = b.st[1];
        if (nloc == 0u) { xcd_barrier_complete(bar, b.x, nloc, nx); b.st[0] = nloc; b.st[1] = nx; }
        const unsigned old = xb_add(&bar[XB_XSUB(b.x)], 1u);
        const unsigned gen = old / nloc;
        if (old + 1u == (gen + 1u) * nloc) {
            __builtin_amdgcn_fence(__ATOMIC_RELEASE, "agent");
            asm volatile("s_waitcnt vmcnt(0)" ::: "memory");
            const unsigned og = xb_add(&bar[XB_TOP], 1u);
            const unsigned tg = og / nx;
            if (og + 1u == (tg + 1u) * nx) xb_add(&bar[XB_TOPGEN], 1u);
            else XB_SPIN(xb_ld(&bar[XB_TOPGEN]) == tg, bar);
            __builtin_amdgcn_fence(__ATOMIC_ACQUIRE, "agent");
            xb_add(&bar[XB_XGEN(b.x)], 1u);
            asm volatile("s_waitcnt vmcnt(0)" ::: "memory");
        } else {
            XB_SPIN(xb_ld(&bar[XB_XGEN(b.x)]) == gen, bar);
            __builtin_amdgcn_fence(__ATOMIC_ACQUIRE, "agent");
            asm volatile("s_waitcnt vmcnt(0)" ::: "memory");
        }
    }
    __syncthreads();
}

constexpr int N_PHASES = 15;
__global__ void __launch_bounds__(NTHR, 2) fwd_kernel(Args A) {
    extern __shared__ __attribute__((aligned(16))) unsigned char lds_raw[];
    LAS unsigned char* lds = (LAS unsigned char*)lds_raw;
    const int tid = threadIdx.x, lane = tid & 63, wave = __builtin_amdgcn_readfirstlane(tid >> 6);
    const int G = gridDim.x, bx = blockIdx.x;
    unsigned char* ws = A.ws;
#define Wt_in ((bf16*)(ws + WS_WIN))
#define Wt_na ((bf16*)(ws + WS_WNA))
#define Wt_gla ((bf16*)(ws + WS_WGLA))
#define Wt_out ((bf16*)(ws + WS_WOUT))
#define Wt_up ((bf16*)(ws + WS_WUP))
#define Wt_down ((bf16*)(ws + WS_WDOWN))
#define biasp ((float*)(ws + WS_BIAS))
#define U ((bf16*)(ws + WS_U))
#define NAO ((bf16*)(ws + WS_NAO))
#define GLAO ((bf16*)(ws + WS_NAO) + 512)
#define HB ((bf16*)(ws + WS_NAO))
#define PROJ ((bf16*)(ws + WS_PROJ))
#define HDN ((bf16*)(ws + WS_PROJ))
#define ctl ((unsigned*)(ws + WS_CTL))
    const int gw = bx * NWAVES + wave, NGW = G * NWAVES;
    const int lo = A.ph_lo, hi = A.ph_hi;
#ifndef PH_MASK
#define PH_MASK 0x1ff
#endif
#define PHM(b) ((PH_MASK >> (b)) & 1)
#define IN(k) (lo <= (k) && (k) < hi)
    if (tid < 2) ((volatile LAS unsigned*)(lds + LDS_BYTES - 64))[tid] = 0u;
    __syncthreads();
    XcdBarrier xbar; xbar.bar = ctl + 4096; xbar.x = 0; xbar.st = nullptr;
    if (A.coop) xbar = xcd_barrier_post(ctl + 4096, (volatile LAS unsigned*)(lds + LDS_BYTES - 64));
#define SEAM(k) do { if (IN(k) && IN((k) + 1)) { if ((k) == 0) cg::this_grid().sync(); else xcd_barrier(xbar); } } while (0)

    if (PHM(0) && IN(0)) {
        LAS float* scr = (LAS float*)(lds + wave * 16384);
        constexpr int I_IN = (DM / 64) * (5152 / 32), I_BR = (512 / 64) * (DM / 32), I_OUT = (DM / 64) * (DM / 32), I_UP = (DM / 64) * (DFF / 32), I_DN = (DFF / 64) * (DM / 32);
        constexpr int NITEMS = I_IN + 2 * I_BR + I_OUT + I_UP + I_DN;
        for (int pass = 0; pass < 2; ++pass) {
        if ((pass ^ (wave & 1)) == 0) {
        for (int it = gw; it < NITEMS; it += NGW) {
            int r = it;
            if (r < I_IN) { transpose_item<1>(A.w_in, DM, 5152, Wt_in, scr, r, lane, nullptr); continue; } r -= I_IN;
            if (r < I_BR) { transpose_item<0>(A.w_br_na, 512, DM, Wt_na, scr, r, lane, nullptr, DM, 0); continue; } r -= I_BR;
            if (r < I_BR) { transpose_item<0>(A.w_br_gla, 512, DM, Wt_na, scr, r, lane, nullptr, DM, 512); continue; } r -= I_BR;
            if (r < I_OUT) { transpose_item<0>(A.w_out, DM, DM, Wt_out, scr, r, lane, nullptr); continue; } r -= I_OUT;
            if (r < I_UP) { transpose_item<2>(A.w_up, DM, DFF, Wt_up, scr, r, lane, A.norm_mlp_g); continue; } r -= I_UP;
            transpose_item<3>(A.w_down, DFF, DM, Wt_down, scr, r, lane, nullptr);
        }
        } else {
        for (int m = gw; m < SBTOK; m += NGW) rms_row2_to_bf16(A.x[0] + (size_t)m * DM, A.x[1] + (size_t)m * DM, A.norm_mix_g, U + (size_t)m * DM, (bf16*)(A.out + (size_t)SBTOK * DM) + (size_t)m * DM, lane);
        }
        }
        {   const int gt = bx * NTHR + tid, NGT = G * NTHR;
            { u32x4* zs = (u32x4*)(ws + WS_SSQ1); for (int i = gt; i < (int)((WS_SSQ2 - WS_SSQ1) * 2 / 16); i += NGT) zs[i] = (u32x4){0u, 0u, 0u, 0u}; }
            u32x4* zp = (u32x4*)(Wt_in + (size_t)5152 * DM);
            for (int i = gt; i < 224 * DM * 2 / 16; i += NGT) zp[i] = (u32x4){0u, 0u, 0u, 0u};
            for (int n = gt; n < NP; n += NGT) { float v = 0.f; if (n < 3072) v = A.b_in[n]; else if (n < C_LR) v = A.b_in[n + 32]; else if (n < C_LR + 32) v = A.b_in[3072 + (n - C_LR)]; biasp[n] = v; } }
        __syncthreads();
    }
    SEAM(0);

#pragma unroll 1
    for (int sb = 0; sb < 2; ++sb) {
        const int P = 1 + 7 * sb;
        const int T = sb ? 4096 : 2048, nB = sb ? 16 : 32;
        const float* xsb = A.x[sb]; float* outsb = A.out + (size_t)sb * SBTOK * DM;
        float* ssq1 = (float*)(ws + WS_SSQ1) + sb * SBTOK; float* ssq2 = (float*)(ws + WS_SSQ2) + sb * SBTOK;
        if (PHM(1) && IN(P)) { pg8::Gemm g{sb ? (const bf16*)outsb : (const bf16*)U, Wt_in, SBTOK, NP, DM}; pg8::StaticOrder S; S.init(SBTOK, NP, G, bx);
            pg8::EpiProj E{PROJ, biasp};
            pg8::gemm_phase<pg8::EpiProj, pg8::StaticOrder, true, true>(lds, g, S, E); }
        SEAM(P);
        bf16* QS = (bf16*)(ws + WS_U); bf16* HT = (bf16*)(ws + WS_U + 64 * MiB); float* DD = (float*)(ws + WS_U + 96 * MiB);
        const int nseg = T / GSEG, ngla = nB * 4 * nseg;
        if (IN(P + 1)) {
            const bool na_first = ((bx >> 3) & 1) != 0;
            if (PHM(3) && na_first) na_phase(lds, A, PROJ, NAO, T, nB, ctl + 64 * (1 + sb), tid);
            if (PHM(2)) for (int item = bx; item < ngla; item += G) gla_pass1(lds, A, PROJ, (bf16*)outsb, QS, HT, DD, T, item / (4 * nseg), (item / nseg) & 3, item % nseg, tid);
            if (PHM(3) && !na_first) na_phase(lds, A, PROJ, NAO, T, nB, ctl + 64 * (1 + sb), tid);
        }
        SEAM(P + 1);
        if (IN(P + 2)) {
            if (PHM(2)) for (int item = bx; item < ngla; item += G) gla_pass2(lds, A, PROJ, (const bf16*)outsb, QS, HT, DD, GLAO, T, item / (4 * nseg), (item / nseg) & 3, item % nseg, tid);
        }
        SEAM(P + 2);
        if (PHM(4) && IN(P + 3)) { pg8::Gemm g{NAO, Wt_na, SBTOK, DM, DM}; pg8::StaticOrder S; S.init(SBTOK, DM, G, bx); pg8::EpiBranchFused E{PROJ, U};
            pg8::gemm_phase<pg8::EpiBranchFused, pg8::StaticOrder, true, true>(lds, g, S, E); }
        SEAM(P + 3);
        if (PHM(5) && IN(P + 4)) { pg8::Gemm g{U, Wt_out, SBTOK, DM, DM}; pg8::StaticOrder S; S.init(SBTOK, DM, G, bx);
            pg8::EpiOut E{xsb, HB, ssq1};
            pg8::gemm_phase<pg8::EpiOut, pg8::StaticOrder, true, true>(lds, g, S, E); }
        SEAM(P + 4);
        if (PHM(6) && IN(P + 5)) { pg8::Gemm g{HB, Wt_up, SBTOK, DFF, DM}; pg8::StaticOrder S; S.init(SBTOK, DFF, G, bx);
            pg8::EpiUp E{ssq1, HDN};
            pg8::gemm_phase<pg8::EpiUp, pg8::StaticOrder, true, true>(lds, g, S, E); }
        SEAM(P + 5);
        if (PHM(7) && IN(P + 6)) { pg8::Gemm g{HDN, Wt_down, SBTOK, DM, DFF}; pg8::StaticOrder S; S.init(SBTOK, DM, G, bx);
            pg8::EpiDownNorm E{HB, outsb, ssq2, ctl + 1024 + sb * 256, A.norm_final_g};
            pg8::gemm_phase<pg8::EpiDownNorm, pg8::StaticOrder, true, true, true>(lds, g, S, E); }
        if (sb == 0) SEAM(P + 6);
    }
#undef IN
#undef SEAM
}

extern "C" void kernel_launch(void* const* d_in, const int* in_sizes, int n_in, void* d_out, int out_size, void* d_ws, size_t ws_size, hipStream_t stream) {
    static int grid = 0;
    if (grid == 0) {
        if (n_in != 18 || ws_size < WS_END) { fprintf(stderr, "kernel_launch: unexpected n_in %d / ws_size %zu\n", n_in, ws_size); grid = -1; return; }
        int dev = 0, cus = 0, per_cu = 0;
        hipGetDevice(&dev); hipDeviceGetAttribute(&cus, hipDeviceAttributeMultiprocessorCount, dev);
        if (hipFuncSetAttribute((const void*)fwd_kernel, hipFuncAttributeMaxDynamicSharedMemorySize, LDS_BYTES) != hipSuccess) { fprintf(stderr, "kernel_launch: hipFuncSetAttribute failed\n"); grid = -1; return; }
        if (hipOccupancyMaxActiveBlocksPerMultiprocessor(&per_cu, (const void*)fwd_kernel, NTHR, LDS_BYTES) != hipSuccess || per_cu < 1) { fprintf(stderr, "kernel_launch: occupancy query says %d\n", per_cu); per_cu = 1; }
        (void)hipGetLastError();
        grid = cus * per_cu;
    }
    if (grid < 0) return;
    hipMemsetAsync((char*)d_ws + WS_CTL, 0, 32768, stream);
    Args a{};
    a.x[0] = (const float*)d_in[0]; a.x[1] = (const float*)d_in[1]; a.norm_mix_g = (const float*)d_in[2]; a.w_in = (const float*)d_in[3]; a.b_in = (const float*)d_in[4];
    a.na_rpb = (const float*)d_in[5]; a.gk_w[0] = (const float*)d_in[6]; a.gk_b[0] = (const float*)d_in[7]; a.gk_w[1] = (const float*)d_in[8]; a.gk_b[1] = (const float*)d_in[9];
    a.gla_norm_g = (const float*)d_in[10]; a.w_br_na = (const float*)d_in[11]; a.w_br_gla = (const float*)d_in[12]; a.w_out = (const float*)d_in[13];
    a.norm_mlp_g = (const float*)d_in[14]; a.w_up = (const float*)d_in[15]; a.w_down = (const float*)d_in[16]; a.norm_final_g = (const float*)d_in[17];
    a.out = (float*)d_out; a.ws = (unsigned char*)d_ws;
#if MK_SINGLE
    a.ph_lo = 0; a.ph_hi = N_PHASES; a.coop = 1;
    void* args[] = {&a};
    hipError_t e = hipLaunchCooperativeKernel((const void*)fwd_kernel, dim3(grid), dim3(NTHR), args, LDS_BYTES, stream);
    if (e != hipSuccess) fprintf(stderr, "cooperative launch failed: %s (grid %d)\n", hipGetErrorString(e), grid);
#else
    for (int p = 0; p < N_PHASES; ++p) { a.ph_lo = p; a.ph_hi = p + 1; a.coop = 0;
        hipLaunchKernelGGL(fwd_kernel, dim3(grid), dim3(NTHR), LDS_BYTES, stream, a); }
#endif
}
```
